# Optimizing an MI355X kernel written in HIP

```python
import jax, jax.numpy as jnp
from jax import lax
import numpy as np

D_MODEL = 1024
BATCH = 1
SEQ = 16384
DEPTH = 1
DEC_BATCH = 8
DEC_SEQ = 32
PAST_LEN = 4096

CHUNK = 64
MIX_WIDTH = D_MODEL
CONV_WIDTH = MIX_WIDTH // 2
CONV_HEADS = 8
CONV_K = 3
CONV_HIST = CONV_K - 1
POOL_WIDTH = MIX_WIDTH - CONV_WIDTH
POOL_WINDOWS = (2, 4, 8, 16)
POOL_GROUPS = len(POOL_WINDOWS)
POOL_GROUP = POOL_WIDTH // POOL_GROUPS
POOL_HIST = max(POOL_WINDOWS) - 1
IN_COLS = 3 * CONV_WIDTH + POOL_WIDTH
D_FF = 4 * D_MODEL
PLE_DIM = 256
EPS = 1e-6

kernel_name = "hybrid_conv_pool_streaming_encoder_step"


def _rms(x, g):
    x32 = x.astype(jnp.float32)
    y = x32 * lax.rsqrt(jnp.mean(x32 * x32, axis=-1, keepdims=True) + EPS) * g.astype(jnp.float32)
    return y.astype(x.dtype)


def _conv_mix(bg, cg, v, hist, w_conv):
    L = v.shape[1]
    h = cg * v
    hp = jnp.concatenate([hist.astype(h.dtype), h], axis=1)
    conv = w_conv[0] * hp[:, :L] + w_conv[1] * hp[:, 1:L + 1] + w_conv[2] * hp[:, 2:]
    return bg * conv, hp[:, -CONV_HIST:]


def _pool_mix(u, hist, start, w_pool, pool_scale):
    Bn, L, _ = u.shape
    up = jnp.concatenate([hist.astype(u.dtype), u], axis=1)
    c = jnp.cumsum(up.astype(jnp.float32), axis=1)
    c = jnp.pad(c, ((0, 0), (1, 0), (0, 0)))
    pos = start + jnp.arange(L)
    means = []
    for g, w in enumerate(POOL_WINDOWS):
        sl = slice(g * POOL_GROUP, (g + 1) * POOL_GROUP)
        s = c[:, POOL_HIST + 1:, sl] - c[:, POOL_HIST + 1 - w:POOL_HIST + 1 - w + L, sl]
        cnt = jnp.minimum(pos + 1, w).astype(jnp.float32)
        means.append(s / cnt[None, :, None])
    mean = jnp.concatenate(means, axis=-1)
    d = (mean - u.astype(jnp.float32)).astype(u.dtype).reshape(Bn, L, POOL_GROUPS, POOL_GROUP)
    y = jnp.einsum('blgc,gcd->blgd', d, w_pool).reshape(Bn, L, POOL_WIDTH) * pool_scale
    return y, up[:, -POOL_HIST:]


def _layer(x, p, conv_hist, pool_hist, start, g_mix, w_in, w_conv, w_pool, pool_scale, w_out,
           g_mlp, w_up, w_down, g_ple, w_ple, w_ple_gate):
    h = _rms(x, g_mix)
    z = h @ w_in
    bg = z[..., :CONV_WIDTH]
    cg = z[..., CONV_WIDTH:2 * CONV_WIDTH]
    v = z[..., 2 * CONV_WIDTH:3 * CONV_WIDTH]
    u = z[..., 3 * CONV_WIDTH:]
    a, new_conv = _conv_mix(bg, cg, v, conv_hist, w_conv)
    b, new_pool = _pool_mix(u, pool_hist, start, w_pool, pool_scale)
    x = x + jnp.concatenate([a, b], axis=-1) @ w_out
    f = jax.nn.relu(_rms(x, g_mlp) @ w_up)
    x = x + (f * f) @ w_down
    x = x + (p @ w_ple) * jax.nn.sigmoid(_rms(x, g_ple) @ w_ple_gate)
    return x, new_conv, new_pool


def setup_inputs(seed: int = 0) -> dict:
    key = jax.random.key(seed)
    ks = jax.random.split(key, 24)
    f32 = jnp.float32
    nrm = lambda k, s, sc: jax.random.normal(k, s, f32) * sc
    gain = lambda k, s: 1.0 + 0.05 * jax.random.normal(k, s, f32)
    return {
        "x_prompt": nrm(ks[0], (BATCH, SEQ, D_MODEL), 1.0),
        "x_sample": nrm(ks[1], (DEC_BATCH, DEC_SEQ, D_MODEL), 1.0),
        "state_conv": nrm(ks[2], (DEPTH, DEC_BATCH, CONV_HIST, CONV_WIDTH), 1.0),
        "state_pool": nrm(ks[3], (DEPTH, DEC_BATCH, POOL_HIST, POOL_WIDTH), 1.0),
        "p_prompt": nrm(ks[4], (DEPTH, BATCH, SEQ, PLE_DIM), 1.0),
        "p_sample": nrm(ks[5], (DEPTH, DEC_BATCH, DEC_SEQ, PLE_DIM), 1.0),
        "g_mix": gain(ks[6], (DEPTH, D_MODEL)),
        "w_in": nrm(ks[7], (DEPTH, D_MODEL, IN_COLS), D_MODEL ** -0.5),
        "w_conv": nrm(ks[8], (DEPTH, CONV_K, CONV_WIDTH), CONV_K ** -0.5),
        "w_pool": nrm(ks[9], (DEPTH, POOL_GROUPS, POOL_GROUP, POOL_GROUP), POOL_GROUP ** -0.5),
        "pool_scale": gain(ks[10], (DEPTH, POOL_WIDTH)),
        "w_out": nrm(ks[11], (DEPTH, MIX_WIDTH, D_MODEL), MIX_WIDTH ** -0.5),
        "g_mlp": gain(ks[12], (DEPTH, D_MODEL)),
        "w_up": nrm(ks[13], (DEPTH, D_MODEL, D_FF), D_MODEL ** -0.5),
        "w_down": nrm(ks[14], (DEPTH, D_FF, D_MODEL), D_FF ** -0.5),
        "g_ple": gain(ks[15], (DEPTH, D_MODEL)),
        "w_ple": nrm(ks[16], (DEPTH, PLE_DIM, D_MODEL), PLE_DIM ** -0.5),
        "w_ple_gate": nrm(ks[17], (DEPTH, D_MODEL, D_MODEL), D_MODEL ** -0.5),
        "g_final": gain(ks[18], (D_MODEL,)),
    }


def reference(x_prompt, x_sample, state_conv, state_pool, p_prompt, p_sample, g_mix, w_in, w_conv,
              w_pool, pool_scale, w_out, g_mlp, w_up, w_down, g_ple, w_ple, w_ple_gate, g_final):
    xp = x_prompt
    xs = x_sample
    conv_p_list, pool_p_list, conv_s_list, pool_s_list = [], [], [], []
    zero_conv = jnp.zeros((x_prompt.shape[0], CONV_HIST, CONV_WIDTH), x_prompt.dtype)
    zero_pool = jnp.zeros((x_prompt.shape[0], POOL_HIST, POOL_WIDTH), x_prompt.dtype)
    for i in range(DEPTH):
        params = (g_mix[i], w_in[i], w_conv[i], w_pool[i], pool_scale[i], w_out[i],
                  g_mlp[i], w_up[i], w_down[i], g_ple[i], w_ple[i], w_ple_gate[i])
        xp, cp, pp = _layer(xp, p_prompt[i], zero_conv, zero_pool, 0, *params)
        xs, cs, ps = _layer(xs, p_sample[i], state_conv[i], state_pool[i], PAST_LEN, *params)
        conv_p_list.append(cp)
        pool_p_list.append(pp)
        conv_s_list.append(cs)
        pool_s_list.append(ps)
    y_prompt = _rms(xp, g_final)
    y_sample = _rms(xs, g_final)
    new_conv_prompt = jnp.stack(conv_p_list)
    new_pool_prompt = jnp.stack(pool_p_list)
    new_conv_sample = jnp.stack(conv_s_list)
    new_pool_sample = jnp.stack(pool_s_list)
    return (y_prompt, y_sample, new_conv_prompt, new_pool_prompt, new_conv_sample, new_pool_sample)
```

```cpp
#include <hip/hip_runtime.h>
#include <hip/hip_cooperative_groups.h>
#include <cstdio>
#include <cstdint>
namespace pg8 {
#define PG8_LAS __attribute__((address_space(3)))
typedef unsigned short bf16_t;
typedef short bf16x8 __attribute__((ext_vector_type(8)));
typedef float f32x4 __attribute__((ext_vector_type(4)));
typedef unsigned u32x4 __attribute__((ext_vector_type(4)));
constexpr int BM = 256, BK = 64, HALF = 128, HTB = HALF * BK * 2  , STAGE_BYTES = 8 * HTB, NXCD = 8, WGM = 8;

__host__ __device__ __forceinline__ int lds_byte(int r, int c) { const int st = (r >> 4) * 2 + (c >> 5), rr = r & 15, cc = c & 31, ob = rr * 64 + cc * 2; return st * 1024 + (ob ^ (((ob >> 9) & 1) << 5)); }
__host__ __device__ __forceinline__ void stage_rc(int b, int& R, int& C) { const int st = b / 1024, sb = b % 1024, swz = sb ^ (((sb >> 9) & 1) << 5); R = (st >> 1) * 16 + swz / 64; C = (st & 1) * 32 + (swz % 64) / 2; }
__host__ __device__ __forceinline__ int perm32(int rho) { const int n = rho >> 4, i = rho & 15; return 8 * (i >> 2) + 4 * n + (i & 3); }

struct Unit { int pm, pn; };
struct Gemm { const bf16_t* A; const bf16_t* Bt; int M, N, K; };

struct StaticOrder {
    int nM, nN, nwg, G, c;
    __host__ __device__ void init(int M, int N, int G_, int c_) { nM = M / BM; nN = N / BM; nwg = nM * nN; G = G_; c = c_; }
    __host__ __device__ bool next(int i, Unit& u) const {
        const long L = (long)i * G + c; if (L >= nwg) return false;
        int wgid = (int)L; { const int q = nwg / NXCD, r = nwg % NXCD, xcd = wgid % NXCD, off = wgid / NXCD; wgid = (xcd < r ? xcd * (q + 1) : r * (q + 1) + (xcd - r) * q) + off; }
        const int nig = WGM * nN, gid = wgid / nig, fm = gid * WGM, gsz = (nM - fm) < WGM ? (nM - fm) : WGM;
        u.pm = fm + ((wgid % nig) % gsz); u.pn = (wgid % nig) / gsz; return true;
    }
    __device__ __forceinline__ void a_ready(const Unit&) const {}
    __device__ __forceinline__ void done(const Unit&) const {}
};

__device__ __forceinline__ unsigned cvt_pk_bf16(float lo, float hi) { unsigned r; asm volatile("v_cvt_pk_bf16_f32 %0, %1, %2" : "=v"(r) : "v"(lo), "v"(hi)); return r; }
typedef unsigned u32x2 __attribute__((ext_vector_type(2)));
__device__ __forceinline__ float bf_lo(unsigned w) { return __uint_as_float(w << 16); }
__device__ __forceinline__ float bf_hi(unsigned w) { return __uint_as_float(w & 0xffff0000u); }
__device__ __forceinline__ float dot4(f32x4 a) { return (a[0] * a[0] + a[1] * a[1]) + (a[2] * a[2] + a[3] * a[3]); }

struct EpiZ {
    static constexpr bool PERM = false, AFTER_DRAIN = false;
    bf16_t* Bz; bf16_t* Hh; bf16_t* Uu; const float* rstd0;
    __device__ __forceinline__ void operator()(const f32x4 (&acc)[2][2][4][2], const Unit& u, int ui, int wr, int wc, int fr, int fq) const {
        const int row0 = u.pm * BM + wr * 64 + fr, ch0 = u.pn * 64 + wc * 16 + 4 * fq;
#pragma unroll
        for (int ai = 0; ai < 2; ++ai)
#pragma unroll
            for (int m = 0; m < 4; ++m) { const int r = row0 + ai * HALF + m * 16; const float rs = rstd0[r];
                const f32x4 b = acc[ai][0][m][0] * rs, c = acc[ai][0][m][1] * rs, v = acc[ai][1][m][0] * rs, uu = acc[ai][1][m][1] * rs, h = c * v;
                const size_t off = (size_t)r * 512 + ch0;
                *(u32x2*)(Bz + off) = (u32x2){cvt_pk_bf16(b[0], b[1]), cvt_pk_bf16(b[2], b[3])};
                *(u32x2*)(Hh + off) = (u32x2){cvt_pk_bf16(h[0], h[1]), cvt_pk_bf16(h[2], h[3])};
                *(u32x2*)(Uu + off) = (u32x2){cvt_pk_bf16(uu[0], uu[1]), cvt_pk_bf16(uu[2], uu[3])}; }
    }
};
struct EpiRes {
    static constexpr bool PERM = true, AFTER_DRAIN = false;
    const float* xin_p; const float* xin_s; float* xo; bf16_t* xb; float* ss;
    __device__ __forceinline__ void operator()(const f32x4 (&acc)[2][2][4][2], const Unit& u, int ui, int wr, int wc, int fr, int fq) const {
        const int rl0 = wr * 64 + fr, col0 = u.pn * BM + wc * 32 + 8 * fq;
        const float* xin = (u.pm < 64) ? xin_p + (size_t)u.pm * BM * 1024 : xin_s;
#pragma unroll
        for (int ai = 0; ai < 2; ++ai)
#pragma unroll
            for (int m = 0; m < 4; ++m) { const int rl = rl0 + ai * HALF + m * 16; const size_t ro = (size_t)(u.pm * BM + rl) * 1024 + col0; const float* xi = xin + (size_t)rl * 1024 + col0; float s = 0.f;
#pragma unroll
                for (int bj = 0; bj < 2; ++bj) { const f32x4 x0 = *(const f32x4*)(xi + bj * HALF), x1 = *(const f32x4*)(xi + bj * HALF + 4);
                    const f32x4 o0 = x0 + acc[ai][bj][m][0], o1 = x1 + acc[ai][bj][m][1];
                    *(f32x4*)(xo + ro + bj * HALF) = o0; *(f32x4*)(xo + ro + bj * HALF + 4) = o1;
                    u32x4 w; w.x = cvt_pk_bf16(o0[0], o0[1]); w.y = cvt_pk_bf16(o0[2], o0[3]); w.z = cvt_pk_bf16(o1[0], o1[1]); w.w = cvt_pk_bf16(o1[2], o1[3]);
                    *(u32x4*)(xb + ro + bj * HALF) = w; s += dot4(o0) + dot4(o1); }
                s += __shfl_xor(s, 16); s += __shfl_xor(s, 32);
                if (fq == 0) ss[(size_t)(u.pm * BM + rl) * 16 + u.pn * 4 + wc] = s;
                asm volatile("" ::: "memory"); }
    }
};
struct EpiUp {
    static constexpr bool PERM = true, AFTER_DRAIN = false;
    bf16_t* F; const PG8_LAS float* rs;
    __device__ __forceinline__ void operator()(const f32x4 (&acc)[2][2][4][2], const Unit& u, int ui, int wr, int wc, int fr, int fq) const {
        const int rl0 = wr * 64 + fr, col0 = u.pn * BM + wc * 32 + 8 * fq;
#pragma unroll
        for (int ai = 0; ai < 2; ++ai)
#pragma unroll
            for (int m = 0; m < 4; ++m) { const int rl = rl0 + ai * HALF + m * 16; const float r1 = rs[ui * 256 + rl]; bf16_t* rowp = F + (size_t)(u.pm * BM + rl) * 4096 + col0;
#pragma unroll
                for (int bj = 0; bj < 2; ++bj) { f32x4 v0 = acc[ai][bj][m][0] * r1, v1 = acc[ai][bj][m][1] * r1;
#pragma unroll
                    for (int j = 0; j < 4; ++j) { v0[j] = fmaxf(v0[j], 0.f); v1[j] = fmaxf(v1[j], 0.f); }
                    v0 = v0 * v0; v1 = v1 * v1;
                    u32x4 w; w.x = cvt_pk_bf16(v0[0], v0[1]); w.y = cvt_pk_bf16(v0[2], v0[3]); w.z = cvt_pk_bf16(v1[0], v1[1]); w.w = cvt_pk_bf16(v1[2], v1[3]);
                    *(u32x4*)(rowp + bj * HALF) = w; } }
    }
};
struct EpiBf {
    static constexpr bool PERM = true, AFTER_DRAIN = false;
    bf16_t* O;
    __device__ __forceinline__ void operator()(const f32x4 (&acc)[2][2][4][2], const Unit& u, int ui, int wr, int wc, int fr, int fq) const {
        const int rl0 = wr * 64 + fr, col0 = u.pn * BM + wc * 32 + 8 * fq;
#pragma unroll
        for (int ai = 0; ai < 2; ++ai)
#pragma unroll
            for (int m = 0; m < 4; ++m) { bf16_t* rowp = O + (size_t)(u.pm * BM + rl0 + ai * HALF + m * 16) * 1024 + col0;
#pragma unroll
                for (int bj = 0; bj < 2; ++bj) { const f32x4 v0 = acc[ai][bj][m][0], v1 = acc[ai][bj][m][1];
                    u32x4 w; w.x = cvt_pk_bf16(v0[0], v0[1]); w.y = cvt_pk_bf16(v0[2], v0[3]); w.z = cvt_pk_bf16(v1[0], v1[1]); w.w = cvt_pk_bf16(v1[2], v1[3]);
                    *(u32x4*)(rowp + bj * HALF) = w; } }
    }
};
struct EpiGate {
    static constexpr bool PERM = true, AFTER_DRAIN = false;
    float* X; const bf16_t* PL; const PG8_LAS float* rs; float* ss;
    __device__ __forceinline__ void operator()(const f32x4 (&acc)[2][2][4][2], const Unit& u, int ui, int wr, int wc, int fr, int fq) const {
        const int rl0 = wr * 64 + fr, col0 = u.pn * BM + wc * 32 + 8 * fq;
#pragma unroll
        for (int ai = 0; ai < 2; ++ai)
#pragma unroll
            for (int m = 0; m < 4; ++m) { const int rl = rl0 + ai * HALF + m * 16; const float r1 = rs[ui * 256 + rl] * -1.44269504089f; const size_t ro = (size_t)(u.pm * BM + rl) * 1024 + col0; float s = 0.f;
#pragma unroll
                for (int bj = 0; bj < 2; ++bj) { const f32x4 x0 = *(const f32x4*)(X + ro + bj * HALF), x1 = *(const f32x4*)(X + ro + bj * HALF + 4); const u32x4 pw = *(const u32x4*)(PL + ro + bj * HALF);
                    const f32x4 p0 = (f32x4){bf_lo(pw.x), bf_hi(pw.x), bf_lo(pw.y), bf_hi(pw.y)}, p1 = (f32x4){bf_lo(pw.z), bf_hi(pw.z), bf_lo(pw.w), bf_hi(pw.w)};
                    f32x4 g0 = acc[ai][bj][m][0] * r1, g1 = acc[ai][bj][m][1] * r1;
#pragma unroll
                    for (int j = 0; j < 4; ++j) { g0[j] = __builtin_amdgcn_rcpf(1.0f + __builtin_amdgcn_exp2f(g0[j])); g1[j] = __builtin_amdgcn_rcpf(1.0f + __builtin_amdgcn_exp2f(g1[j])); }
                    const f32x4 o0 = x0 + p0 * g0, o1 = x1 + p1 * g1;
                    *(f32x4*)(X + ro + bj * HALF) = o0; *(f32x4*)(X + ro + bj * HALF + 4) = o1; s += dot4(o0) + dot4(o1); }
                s += __shfl_xor(s, 16); s += __shfl_xor(s, 32);
                if (fq == 0) ss[(size_t)(u.pm * BM + rl) * 16 + u.pn * 4 + wc] = s;
                asm volatile("" ::: "memory"); }
    }
};

template <class Epi, class Sched, bool ALIGN_EPI = false, bool SP2 = false>
__device__ __forceinline__ void gemm_phase(PG8_LAS unsigned char* lds, const Gemm g, const Sched& S, const Epi& E) {
    int tid_ = threadIdx.x; asm volatile("" : "+v"(tid_));
    const int tid = tid_, wid = __builtin_amdgcn_readfirstlane(tid >> 6), lane = tid & 63, wr = wid >> 2, wc = wid & 3, fr = lane & 15, fq = lane >> 4;
    const int K = g.K, nt = K / BK;
    unsigned voffA[2], voffB[2];
#pragma unroll
    for (int i = 0; i < 2; ++i) { int R, C; stage_rc(tid * 16 + i * 8192, R, C); const int Rb = Epi::PERM ? ((R & ~31) + perm32(R & 31)) : R;
        voffA[i] = (unsigned)(R * K + C) * 2u; voffB[i] = (unsigned)(Rb * K + C) * 2u; }
    const size_t kstep = (size_t)(BK * 2);
    const size_t hstep = (size_t)HALF * K * 2;
    const size_t tstep = 2 * hstep;
    const unsigned ldsw = (unsigned)wid * 1024u;
    const int aoff = lds_byte(wr * 64 + fr, fq * 8), boff = lds_byte(wc * 32 + fr, fq * 8);
#define PG8_SA(b, h) (((b) * 2 + (h)) * HTB)
#define PG8_SB(b, h) ((4 + (b) * 2 + (h)) * HTB)
#define PG8_STAGE(bufoff, gbase, voff) do { _Pragma("unroll") for (int _i = 0; _i < 2; ++_i) \
        __builtin_amdgcn_global_load_lds((const unsigned*)((const char*)(gbase) + (voff)[_i]), (PG8_LAS unsigned*)(lds + (bufoff) + ldsw + _i * 8192), 16, 0, 0); } while (0)
#define PG8_LDA(dst, b, h) do { _Pragma("unroll") for (int m = 0; m < 4; ++m) _Pragma("unroll") for (int k = 0; k < 2; ++k) dst[m][k] = *(const PG8_LAS bf16x8*)(lds + PG8_SA(b, h) + aoff + m * 2048 + k * 1024); } while (0)
#define PG8_LDB(dst, b, h) do { _Pragma("unroll") for (int n = 0; n < 2; ++n) _Pragma("unroll") for (int k = 0; k < 2; ++k) dst[n][k] = *(const PG8_LAS bf16x8*)(lds + PG8_SB(b, h) + boff + n * 2048 + k * 1024); } while (0)
#define PG8_MMA(ai, bj, At, Bt) do { __builtin_amdgcn_s_setprio(1); _Pragma("unroll") for (int m = 0; m < 4; ++m) _Pragma("unroll") for (int n = 0; n < 2; ++n) _Pragma("unroll") for (int k = 0; k < 2; ++k) \
        acc[ai][bj][m][n] = __builtin_amdgcn_mfma_f32_16x16x32_bf16(Bt[n][k], At[m][k], acc[ai][bj][m][n], 0, 0, 0); __builtin_amdgcn_s_setprio(0); } while (0)
#define PG8_WAIT_V(n) asm volatile("s_waitcnt vmcnt(" #n ")" ::: "memory")
#define PG8_WAIT_L(n) asm volatile("s_waitcnt lgkmcnt(" #n ")" ::: "memory")
#define PG8_BAR __builtin_amdgcn_s_barrier()
#define PG8_SCHED __builtin_amdgcn_sched_barrier(0)
    Unit cur, nxt; int ui = 0;
    if (!S.next(0, cur)) return;
    f32x4 acc[2][2][4][2];
#pragma unroll
    for (int a = 0; a < 2; ++a)
#pragma unroll
        for (int b = 0; b < 2; ++b)
#pragma unroll
            for (int m = 0; m < 4; ++m)
#pragma unroll
                for (int n = 0; n < 2; ++n) acc[a][b][m][n] = (f32x4){0.f, 0.f, 0.f, 0.f};
    bf16x8 At[4][2], B0[2][2], B1[2][2];
    const char* cA = (const char*)g.A + (size_t)cur.pm * tstep; const char* cB = (const char*)g.Bt + (size_t)cur.pn * tstep;
    S.a_ready(cur);
    if constexpr (SP2) {
        PG8_STAGE(PG8_SB(0, 0), cB, voffB); PG8_STAGE(PG8_SB(0, 1), cB + hstep, voffB); PG8_STAGE(PG8_SA(0, 0), cA, voffA); PG8_STAGE(PG8_SA(0, 1), cA + hstep, voffA);
        if (wr == 1) PG8_BAR;
        PG8_WAIT_V(2); PG8_BAR;
        PG8_STAGE(PG8_SB(1, 0), cB + kstep, voffB); PG8_STAGE(PG8_SA(1, 0), cA + kstep, voffA); PG8_STAGE(PG8_SB(1, 1), cB + hstep + kstep, voffB);
        PG8_WAIT_V(6); PG8_BAR;
    } else {
        PG8_STAGE(PG8_SB(0, 0), cB, voffB); PG8_STAGE(PG8_SA(0, 0), cA, voffA); PG8_STAGE(PG8_SB(0, 1), cB + hstep, voffB); PG8_STAGE(PG8_SA(0, 1), cA + hstep, voffA);
        if (wr == 1) PG8_BAR;
        PG8_WAIT_V(4); PG8_BAR;
        PG8_STAGE(PG8_SB(1, 0), cB + kstep, voffB); PG8_STAGE(PG8_SA(1, 0), cA + kstep, voffA); PG8_STAGE(PG8_SB(1, 1), cB + hstep + kstep, voffB);
        PG8_WAIT_V(6); PG8_BAR;
    }
    for (;;) {
        const bool has_next = S.next(ui + 1, nxt);
        const char* nA = has_next ? (const char*)g.A + (size_t)nxt.pm * tstep : cA; const char* nB = has_next ? (const char*)g.Bt + (size_t)nxt.pn * tstep : cB;
        for (int t = 0; t < nt; t += 2) {
            const bool last = (t == nt - 2);
            const char* a1 = cA + (size_t)(t + 1) * kstep;
            const char* a2 = last ? nA : cA + (size_t)(t + 2) * kstep; const char* b2 = last ? nB : cB + (size_t)(t + 2) * kstep;
            const char* a3 = a2 + kstep; const char* b3 = b2 + kstep;
            if (last && has_next) S.a_ready(nxt);
            if constexpr (SP2) {
            PG8_LDB(B0, 0, 0); PG8_LDB(B1, 0, 1); PG8_SCHED; PG8_LDA(At, 0, 0); PG8_STAGE(PG8_SA(1, 1), a1 + hstep, voffA);
            PG8_WAIT_V(8); PG8_WAIT_L(0); PG8_BAR; PG8_MMA(0, 0, At, B0); PG8_MMA(0, 1, At, B1); PG8_BAR; PG8_SCHED;
            PG8_LDA(At, 0, 1); PG8_STAGE(PG8_SB(0, 0), b2, voffB); PG8_STAGE(PG8_SB(0, 1), b2 + hstep, voffB); PG8_STAGE(PG8_SA(0, 0), a2, voffA);
            PG8_WAIT_V(8); PG8_WAIT_L(0); PG8_BAR; PG8_MMA(1, 0, At, B0); PG8_MMA(1, 1, At, B1); PG8_BAR; PG8_SCHED;
            PG8_LDB(B0, 1, 0); PG8_LDB(B1, 1, 1); PG8_SCHED; PG8_LDA(At, 1, 0); PG8_STAGE(PG8_SA(0, 1), a2 + hstep, voffA);
            PG8_WAIT_V(8); PG8_WAIT_L(0); PG8_BAR; PG8_MMA(0, 0, At, B0); PG8_MMA(0, 1, At, B1); PG8_BAR; PG8_SCHED;
            PG8_LDA(At, 1, 1); PG8_STAGE(PG8_SB(1, 0), b3, voffB); PG8_STAGE(PG8_SB(1, 1), b3 + hstep, voffB); PG8_STAGE(PG8_SA(1, 0), a3, voffA);
            PG8_WAIT_V(8); PG8_WAIT_L(0); PG8_BAR; PG8_MMA(1, 0, At, B0); PG8_MMA(1, 1, At, B1); PG8_BAR; PG8_SCHED;
            } else {
            PG8_LDB(B0, 0, 0); PG8_SCHED; PG8_LDA(At, 0, 0); PG8_STAGE(PG8_SA(1, 1), a1 + hstep, voffA);
            PG8_WAIT_L(8); PG8_BAR; PG8_WAIT_L(0); PG8_MMA(0, 0, At, B0); PG8_BAR; PG8_SCHED;
            PG8_LDB(B1, 0, 1); PG8_STAGE(PG8_SB(0, 0), b2, voffB);
            PG8_BAR; PG8_WAIT_L(0); PG8_MMA(0, 1, At, B1); PG8_BAR;
            PG8_LDA(At, 0, 1); PG8_STAGE(PG8_SA(0, 0), a2, voffA);
            PG8_BAR; PG8_WAIT_L(0); PG8_MMA(1, 0, At, B0); PG8_BAR; PG8_SCHED;
            PG8_STAGE(PG8_SB(0, 1), b2 + hstep, voffB);
            PG8_WAIT_V(6); PG8_BAR; PG8_MMA(1, 1, At, B1); PG8_BAR;
            PG8_LDB(B0, 1, 0); PG8_SCHED; PG8_LDA(At, 1, 0); PG8_STAGE(PG8_SA(0, 1), a2 + hstep, voffA);
            PG8_WAIT_L(8); PG8_BAR; PG8_WAIT_L(0); PG8_MMA(0, 0, At, B0); PG8_BAR; PG8_SCHED;
            PG8_LDB(B1, 1, 1); PG8_STAGE(PG8_SB(1, 0), b3, voffB);
            PG8_BAR; PG8_WAIT_L(0); PG8_MMA(0, 1, At, B1); PG8_BAR;
            PG8_LDA(At, 1, 1); PG8_STAGE(PG8_SA(1, 0), a3, voffA);
            PG8_BAR; PG8_WAIT_L(0); PG8_MMA(1, 0, At, B0); PG8_BAR; PG8_SCHED;
            PG8_STAGE(PG8_SB(1, 1), b3 + hstep, voffB);
            PG8_WAIT_V(6); PG8_BAR; PG8_MMA(1, 1, At, B1); PG8_BAR;
            }
        }
        if constexpr (ALIGN_EPI) { if (wr == 0) PG8_BAR; }
        if constexpr (!Epi::AFTER_DRAIN) { E(acc, cur, ui, wr, wc, fr, fq); S.done(cur); }
        if (!has_next) break;
#pragma unroll
        for (int a = 0; a < 2; ++a)
#pragma unroll
            for (int b = 0; b < 2; ++b)
#pragma unroll
                for (int m = 0; m < 4; ++m)
#pragma unroll
                    for (int n = 0; n < 2; ++n) acc[a][b][m][n] = (f32x4){0.f, 0.f, 0.f, 0.f};
        cur = nxt; cA = nA; cB = nB; ++ui;
        if constexpr (ALIGN_EPI) { if (wr == 1) PG8_BAR; }
    }
    PG8_WAIT_V(0);
    if constexpr (!ALIGN_EPI) { if (wr == 0) PG8_BAR; }
    PG8_BAR;
    if constexpr (Epi::AFTER_DRAIN) { E.fused(acc, cur, wr, wc, fr, fq, lds, wid, lane); S.done(cur); }
#undef PG8_SA
#undef PG8_SB
#undef PG8_STAGE
#undef PG8_LDA
#undef PG8_LDB
#undef PG8_MMA
#undef PG8_WAIT_V
#undef PG8_WAIT_L
#undef PG8_BAR
#undef PG8_SCHED
}
}

#ifndef MK_N_LAUNCHES
#define MK_N_LAUNCHES 1
#endif
namespace cg = cooperative_groups;
namespace mk {
#define LAS __attribute__((address_space(3)))
typedef unsigned short bf16;
typedef float f32x4 __attribute__((ext_vector_type(4)));
typedef unsigned u32x4 __attribute__((ext_vector_type(4)));
typedef unsigned u32x2 __attribute__((ext_vector_type(2)));
constexpr int NWAVES = 8, NTHR = 512;
constexpr int D = 1024, MP = 16384, MS = 256, M = MP + MS, NIN = 2048, CW = 512, FF = 4096, PLE = 256, SEQS = 32, NB = 8;
constexpr float EPS = 1e-6f;
constexpr size_t O_Y = 0, O_CP = (size_t)M * D, O_PP = O_CP + 2 * CW, O_CS = O_PP + 15 * CW, O_PS = O_CS + NB * 2 * CW, O_END = O_PS + NB * 15 * CW;
constexpr size_t MiB = 1u << 20;
constexpr size_t WS_RSTD0 = 1 * MiB, WS_SS1 = 2 * MiB, WS_SS2 = 7 * MiB / 2, WS_SS3 = 5 * MiB;
constexpr size_t WS_WIN = 7 * MiB, WS_WOUT = 11 * MiB, WS_WUP = 13 * MiB, WS_WDN = 21 * MiB, WS_WGT = 29 * MiB, WS_WPL = 31 * MiB;
constexpr size_t WS_F = 32 * MiB;
constexpr size_t ZB = (size_t)M * CW * 2;
constexpr size_t WS_BZ = WS_F, WS_H = WS_F + ZB, WS_U = WS_F + 2 * ZB;
constexpr size_t WS_R1 = 162 * MiB;
constexpr size_t WS_R2 = 195 * MiB;
constexpr size_t WS_PB = 228 * MiB;
constexpr size_t WS_END = 237 * MiB;
static_assert(WS_F + (size_t)M * FF * 2 <= WS_R1 && WS_R1 + (size_t)M * D * 2 <= WS_R2 && WS_R2 + (size_t)M * D * 2 <= WS_PB && WS_PB + (size_t)M * PLE * 2 <= WS_END, "ws map");
static_assert((size_t)M * 16 * 4 <= 3 * MiB / 2, "ss size");
constexpr int RING_BYTES = 131072, RS_OFF = RING_BYTES, RS_BYTES = 8 * 256 * 4, LDS_BYTES = 147456;

__device__ __forceinline__ unsigned pk2(float lo, float hi) { return pg8::cvt_pk_bf16(lo, hi); }
__device__ __forceinline__ float bflo(unsigned w) { return __uint_as_float(w << 16); }
__device__ __forceinline__ float bfhi(unsigned w) { return __uint_as_float(w & 0xffff0000u); }
__device__ __forceinline__ void unpack8(const u32x4 w, float (&f)[8]) { f[0] = bflo(w.x); f[1] = bfhi(w.x); f[2] = bflo(w.y); f[3] = bfhi(w.y); f[4] = bflo(w.z); f[5] = bfhi(w.z); f[6] = bflo(w.w); f[7] = bfhi(w.w); }
__device__ __forceinline__ u32x4 pack8(const float (&f)[8]) { u32x4 w; w.x = pk2(f[0], f[1]); w.y = pk2(f[2], f[3]); w.z = pk2(f[4], f[5]); w.w = pk2(f[6], f[7]); return w; }
__device__ __forceinline__ float wave_sum(float v) {
#pragma unroll
    for (int o = 1; o < 64; o <<= 1) v += __shfl_xor(v, o);
    return v;
}
#define LDS_WAIT() asm volatile("s_waitcnt lgkmcnt(0)" ::: "memory")

struct Args { const float* in[19]; float* out; unsigned char* ws; long long ph_lo, ph_hi; };

__device__ __forceinline__ int perm_in(int n) { const int T = n >> 9, ch = n & 511; return (ch >> 6) * 256 + (T >> 1) * 128 + ((ch >> 4) & 3) * 32 + (T & 1) * 16 + (ch & 15); }

__device__ __forceinline__ void transpose_item(const float* W, int N, const float* g, bf16* WT, int ldk, int mode, LAS float* scr, int item, int lane) {
    const int nblk = N / 32, kb = item / nblk, nb = item % nblk, k0 = 64 * kb, n0 = 32 * nb;
#pragma unroll 8
    for (int i = 0; i < 32; ++i) { const int kk = 2 * i + (lane >> 5); float v = W[(size_t)(k0 + kk) * N + n0 + (lane & 31)]; if (g) v *= g[k0 + kk]; scr[kk * 33 + (lane & 31)] = v; }
    LDS_WAIT();
    const int c = lane & 7;
#pragma unroll
    for (int j = 0; j < 4; ++j) { const int n = (lane >> 3) + 8 * j; const LAS float* s = scr + (8 * c) * 33 + n; const int nn = n0 + n; const int row = mode ? perm_in(nn) : nn;
        u32x4 o; o.x = pk2(s[0 * 33], s[1 * 33]); o.y = pk2(s[2 * 33], s[3 * 33]); o.z = pk2(s[4 * 33], s[5 * 33]); o.w = pk2(s[6 * 33], s[7 * 33]);
        *(u32x4*)(WT + (size_t)row * ldk + k0 + 8 * c) = o; }
    LDS_WAIT();
}

__device__ __forceinline__ void p0_prologue(const Args& a, unsigned char* lds, int G) {
    const int tid = threadIdx.x, lane = tid & 63, wave = __builtin_amdgcn_readfirstlane(tid >> 6);
    const int gw = blockIdx.x * NWAVES + wave, NGW = G * NWAVES;
    unsigned char* ws = a.ws;
    const float *g_mix = a.in[6], *w_in = a.in[7], *w_pool = a.in[9], *pscale = a.in[10], *w_out = a.in[11], *g_mlp = a.in[12], *w_up = a.in[13], *w_down = a.in[14], *g_ple = a.in[15], *w_ple = a.in[16], *w_gate = a.in[17];
    bf16 *Win_t = (bf16*)(ws + WS_WIN), *Wout_t = (bf16*)(ws + WS_WOUT), *Wup_t = (bf16*)(ws + WS_WUP), *Wdn_t = (bf16*)(ws + WS_WDN), *Wgt_t = (bf16*)(ws + WS_WGT), *Wpl_t = (bf16*)(ws + WS_WPL);
    for (int T0 = gw * 64; T0 < 65536; T0 += NGW * 64) {
        const int n = (T0 & 1023) + lane, kb = T0 >> 10, g = kb >> 4, c0 = (kb & 15) * 8;
        float accv[8];
#pragma unroll
        for (int i = 0; i < 8; ++i) accv[i] = 0.f;
        const float* wo = w_out + (size_t)(512 + g * 128) * D + n; const float* sc = pscale + g * 128; const float* wp = w_pool + (size_t)(g * 128 + c0) * 128;
#pragma unroll 8
        for (int d = 0; d < 128; ++d) { const float w = sc[d] * wo[(size_t)d * D];
#pragma unroll
            for (int i = 0; i < 8; ++i) accv[i] += wp[i * 128 + d] * w; }
        *(u32x4*)(Wout_t + (size_t)n * D + 512 + g * 128 + c0) = pack8(accv);
    }
    LAS float* scr = (LAS float*)((LAS unsigned char*)lds + wave * 16384);
    constexpr int I_IN = (D / 64) * (NIN / 32), I_OUT = (512 / 64) * (D / 32), I_UP = (D / 64) * (FF / 32), I_DN = (FF / 64) * (D / 32), I_GT = (D / 64) * (D / 32), I_PL = (PLE / 64) * (D / 32);
    constexpr int NITEMS = I_IN + I_OUT + I_UP + I_DN + I_GT + I_PL;
    for (int it = gw; it < NITEMS; it += NGW) {
        int r = it;
        if (r < I_IN) { transpose_item(w_in, NIN, g_mix, Win_t, D, 1, scr, r, lane); continue; } r -= I_IN;
        if (r < I_OUT) { transpose_item(w_out, D, nullptr, Wout_t, D, 0, scr, r, lane); continue; } r -= I_OUT;
        if (r < I_UP) { transpose_item(w_up, FF, g_mlp, Wup_t, D, 0, scr, r, lane); continue; } r -= I_UP;
        if (r < I_DN) { transpose_item(w_down, D, nullptr, Wdn_t, FF, 0, scr, r, lane); continue; } r -= I_DN;
        if (r < I_GT) { transpose_item(w_gate, D, g_ple, Wgt_t, D, 0, scr, r, lane); continue; } r -= I_GT;
        transpose_item(w_ple, D, nullptr, Wpl_t, PLE, 0, scr, r, lane);
    }
    const float *xp = a.in[0], *xs = a.in[1]; bf16* xb = (bf16*)(ws + WS_R1); float* rstd0 = (float*)(ws + WS_RSTD0);
    for (int m = gw; m < M; m += NGW) {
        const f32x4* xr = (const f32x4*)(m < MP ? xp + (size_t)m * D : xs + (size_t)(m - MP) * D) + lane;
        f32x4 v[4]; float s = 0.f;
#pragma unroll
        for (int j = 0; j < 4; ++j) { v[j] = xr[64 * j]; s += (v[j][0] * v[j][0] + v[j][1] * v[j][1]) + (v[j][2] * v[j][2] + v[j][3] * v[j][3]); }
        s = wave_sum(s);
        if (lane == 0) rstd0[m] = rsqrtf(s * (1.f / D) + EPS);
        u32x2* o = (u32x2*)(xb + (size_t)m * D) + lane;
#pragma unroll
        for (int j = 0; j < 4; ++j) o[64 * j] = (u32x2){pk2(v[j][0], v[j][1]), pk2(v[j][2], v[j][3])};
    }
    const float *pp = a.in[4], *ps = a.in[5]; bf16* pb = (bf16*)(ws + WS_PB);
    for (int i = blockIdx.x * NTHR + tid; i < M * PLE / 8; i += G * NTHR) {
        const f32x4* src = (const f32x4*)(i < MP * PLE / 8 ? pp + (size_t)i * 8 : ps + (size_t)(i - MP * PLE / 8) * 8);
        const f32x4 v0 = src[0], v1 = src[1]; u32x4 w; w.x = pk2(v0[0], v0[1]); w.y = pk2(v0[2], v0[3]); w.z = pk2(v1[0], v1[1]); w.w = pk2(v1[2], v1[3]);
        *(u32x4*)(pb + (size_t)i * 8) = w;
    }
}

__device__ __forceinline__ void p2_mixer(const Args& a, int G) {
    const int tid = threadIdx.x, lane = tid & 63, wave = __builtin_amdgcn_readfirstlane(tid >> 6);
    const int gw = blockIdx.x * NWAVES + wave, NGW = G * NWAVES;
    unsigned char* ws = a.ws;
    const bf16 *Bz = (const bf16*)(ws + WS_BZ), *Hh = (const bf16*)(ws + WS_H), *Uu = (const bf16*)(ws + WS_U); bf16* mixA = (bf16*)(ws + WS_R1);
    const float *st_conv = a.in[2], *st_pool = a.in[3], *w_conv = a.in[8];
    for (int r = gw; r < M; r += NGW) {
        const bool samp = r >= MP; const int t = samp ? ((r - MP) & (SEQS - 1)) : r, b = samp ? ((r - MP) >> 5) : 0; const int ch = lane * 8;
        float h0[8], h1[8], h2[8], bz[8], w0[8], w1[8], w2[8], o[8];
        unpack8(*(const u32x4*)(Hh + (size_t)r * CW + ch), h0); unpack8(*(const u32x4*)(Bz + (size_t)r * CW + ch), bz);
        if (t >= 1) unpack8(*(const u32x4*)(Hh + (size_t)(r - 1) * CW + ch), h1);
        else {
#pragma unroll
            for (int i = 0; i < 8; ++i) h1[i] = samp ? st_conv[(size_t)(b * 2 + 1) * CW + ch + i] : 0.f; }
        if (t >= 2) unpack8(*(const u32x4*)(Hh + (size_t)(r - 2) * CW + ch), h2);
        else {
#pragma unroll
            for (int i = 0; i < 8; ++i) h2[i] = samp ? st_conv[(size_t)(b * 2 + t) * CW + ch + i] : 0.f; }
#pragma unroll
        for (int i = 0; i < 8; ++i) { w0[i] = w_conv[ch + i]; w1[i] = w_conv[CW + ch + i]; w2[i] = w_conv[2 * CW + ch + i]; }
#pragma unroll
        for (int i = 0; i < 8; ++i) o[i] = bz[i] * (w0[i] * h2[i] + w1[i] * h1[i] + w2[i] * h0[i]);
        *(u32x4*)(mixA + (size_t)r * D + ch) = pack8(o);
    }
    for (int it = gw; it < (M / 4) * 4; it += NGW) {
        const int g = it & 3, r = (it >> 2) * 4 + (lane >> 4), pc = g * 128 + (lane & 15) * 8, w = 2 << g;
        const bool samp = r >= MP; const int t = samp ? ((r - MP) & (SEQS - 1)) : r, b = samp ? ((r - MP) >> 5) : 0;
        float u0[8], s[8], uk[8];
        unpack8(*(const u32x4*)(Uu + (size_t)r * CW + pc), u0);
#pragma unroll
        for (int i = 0; i < 8; ++i) s[i] = u0[i];
        for (int k = 1; k < w; ++k) { const int tt = t - k;
            if (tt >= 0) { unpack8(*(const u32x4*)(Uu + (size_t)(r - k) * CW + pc), uk);
#pragma unroll
                for (int i = 0; i < 8; ++i) s[i] += uk[i]; }
            else if (samp) {
#pragma unroll
                for (int i = 0; i < 8; ++i) s[i] += st_pool[(size_t)(b * 15 + 15 + tt) * CW + pc + i]; } }
        const float inv = 1.0f / (float)(samp ? w : (t + 1 < w ? t + 1 : w));
#pragma unroll
        for (int i = 0; i < 8; ++i) s[i] = s[i] * inv - u0[i];
        *(u32x4*)(mixA + (size_t)r * D + CW + pc) = pack8(s);
    }
    float* out = a.out;
    for (int e = blockIdx.x * NTHR + tid; e < (int)(O_END - O_CP); e += G * NTHR) {
        int q = e; const bf16* src; int row;
        if (q < 2 * CW) { src = Hh; row = MP - 2 + (q >> 9); }
        else if ((q -= 2 * CW) < 15 * CW) { src = Uu; row = MP - 15 + (q >> 9); }
        else if ((q -= 15 * CW) < NB * 2 * CW) { src = Hh; row = MP + (q >> 10) * SEQS + SEQS - 2 + ((q >> 9) & 1); }
        else { q -= NB * 2 * CW; const int b = q / (15 * CW), rem = q - b * 15 * CW; src = Uu; row = MP + b * SEQS + SEQS - 15 + (rem >> 9); }
        out[O_CP + e] = __uint_as_float((unsigned)src[(size_t)row * CW + (q & 511)] << 16);
    }
}

template <class Sched> __device__ __forceinline__ void fill_rstd(LAS float* rs, const Sched& S, const float* ss) {
    pg8::Unit u; const int row = threadIdx.x >> 1, half = threadIdx.x & 1;
    for (int i = 0; i < 8 && S.next(i, u); ++i) {
        const f32x4* p = (const f32x4*)(ss + (size_t)(u.pm * 256 + row) * 16 + half * 8);
        const f32x4 x = p[0], y = p[1]; float s = ((x[0] + x[1]) + (x[2] + x[3])) + ((y[0] + y[1]) + (y[2] + y[3]));
        s += __shfl_xor(s, 1);
        if (half == 0) rs[i * 256 + row] = rsqrtf(s * (1.f / D) + EPS);
    }
    __syncthreads();
}

__device__ __forceinline__ void p7_final(const Args& a, int G) {
    const int tid = threadIdx.x, lane = tid & 63, wave = __builtin_amdgcn_readfirstlane(tid >> 6);
    const int gw = blockIdx.x * NWAVES + wave, NGW = G * NWAVES;
    const float* ss3 = (const float*)(a.ws + WS_SS3); const f32x4* gf = (const f32x4*)a.in[18] + lane;
    f32x4 gv[4];
#pragma unroll
    for (int j = 0; j < 4; ++j) gv[j] = gf[64 * j];
    for (int m = gw; m < M; m += NGW) {
        float s = (lane < 16) ? ss3[(size_t)m * 16 + lane] : 0.f; s = wave_sum(s);
        const float rstd = rsqrtf(s * (1.f / D) + EPS);
        f32x4* xr = (f32x4*)(a.out + (size_t)m * D) + lane;
#pragma unroll
        for (int j = 0; j < 4; ++j) xr[64 * j] = xr[64 * j] * gv[j] * rstd;
    }
}

__global__ void __launch_bounds__(NTHR, 2) mk_fwd(Args a) {
    extern __shared__ __attribute__((aligned(16))) unsigned char lds[];
    PG8_LAS unsigned char* L = (PG8_LAS unsigned char*)lds;
    LAS float* rs = (LAS float*)(L + RS_OFF);
    const int G = gridDim.x, c = blockIdx.x;
    unsigned char* ws = a.ws;
    const int lo = (int)a.ph_lo, hi = (int)a.ph_hi;
#define IN(k) (lo <= (k) && (k) < hi)
#define SEAM(k) do { if (IN(k) && IN((k) + 1)) cg::this_grid().sync(); } while (0)
    bf16 *Win_t = (bf16*)(ws + WS_WIN), *Wout_t = (bf16*)(ws + WS_WOUT), *Wup_t = (bf16*)(ws + WS_WUP), *Wdn_t = (bf16*)(ws + WS_WDN), *Wgt_t = (bf16*)(ws + WS_WGT), *Wpl_t = (bf16*)(ws + WS_WPL);
    bf16 *R1 = (bf16*)(ws + WS_R1), *R2 = (bf16*)(ws + WS_R2), *PB = (bf16*)(ws + WS_PB), *Fb = (bf16*)(ws + WS_F);
    float *ss1 = (float*)(ws + WS_SS1), *ss2 = (float*)(ws + WS_SS2), *ss3 = (float*)(ws + WS_SS3);

    if (IN(0)) { p0_prologue(a, lds, G); } SEAM(0);
    if (IN(1)) {
        pg8::Gemm g{R1, Win_t, M, NIN, D}; pg8::StaticOrder S; S.init(M, NIN, G, c);
        pg8::EpiZ E{(bf16*)(ws + WS_BZ), (bf16*)(ws + WS_H), (bf16*)(ws + WS_U), (const float*)(ws + WS_RSTD0)};
        pg8::gemm_phase<pg8::EpiZ, pg8::StaticOrder, true, true>(L, g, S, E);
    } SEAM(1);
    if (IN(2)) { p2_mixer(a, G); } SEAM(2);
    if (IN(3)) {
        pg8::Gemm g{R1, Wout_t, M, D, D}; pg8::StaticOrder S; S.init(M, D, G, c);
        pg8::EpiRes E{a.in[0], a.in[1], a.out, R2, ss1};
        pg8::gemm_phase<pg8::EpiRes, pg8::StaticOrder, true, true>(L, g, S, E);
    } SEAM(3);
    if (IN(4)) {
        pg8::Gemm g{R2, Wup_t, M, FF, D}; pg8::StaticOrder S; S.init(M, FF, G, c);
        fill_rstd(rs, S, ss1);
        pg8::EpiUp E{Fb, (const PG8_LAS float*)rs};
        pg8::gemm_phase<pg8::EpiUp, pg8::StaticOrder, true, true>(L, g, S, E);
    } SEAM(4);
    if (IN(5)) {
        { pg8::Gemm g{Fb, Wdn_t, M, D, FF}; pg8::StaticOrder S; S.init(M, D, G, c);
          pg8::EpiRes E{a.out, a.out + (size_t)MP * D, a.out, R1, ss2};
          pg8::gemm_phase<pg8::EpiRes, pg8::StaticOrder, true, true>(L, g, S, E); }
        { pg8::Gemm g{PB, Wpl_t, M, D, PLE}; pg8::StaticOrder S; S.init(M, D, G, c);
          pg8::EpiBf E{R2};
          pg8::gemm_phase<pg8::EpiBf, pg8::StaticOrder, true, true>(L, g, S, E); }
    } SEAM(5);
    if (IN(6)) {
        pg8::Gemm g{R1, Wgt_t, M, D, D}; pg8::StaticOrder S; S.init(M, D, G, c);
        fill_rstd(rs, S, ss2);
        pg8::EpiGate E{a.out, R2, (const PG8_LAS float*)rs, ss3};
        pg8::gemm_phase<pg8::EpiGate, pg8::StaticOrder, true, true>(L, g, S, E);
    } SEAM(6);
    if (IN(7)) { p7_final(a, G); }
#undef IN
#undef SEAM
}
}

extern "C" void kernel_launch(void* const* d_in, const int* in_sizes, int n_in, void* d_out, int out_size, void* d_ws, size_t ws_size, hipStream_t stream) {
    using namespace mk;
    static int grid = 0;
    if (grid == 0) {
        if (n_in != 19 || out_size != (int)O_END || ws_size < WS_END) { fprintf(stderr, "kernel_launch: unexpected shapes (n_in %d, out %d, ws %zu)\n", n_in, out_size, ws_size); grid = -1; return; }
        int dev = 0, cus = 0, per_cu = 0;
        (void)hipGetDevice(&dev); (void)hipDeviceGetAttribute(&cus, hipDeviceAttributeMultiprocessorCount, dev);
        if (hipFuncSetAttribute((const void*)mk_fwd, hipFuncAttributeMaxDynamicSharedMemorySize, LDS_BYTES) != hipSuccess) { fprintf(stderr, "kernel_launch: hipFuncSetAttribute failed\n"); grid = -1; return; }
        if (hipOccupancyMaxActiveBlocksPerMultiprocessor(&per_cu, (const void*)mk_fwd, NTHR, LDS_BYTES) != hipSuccess || per_cu < 1) { fprintf(stderr, "kernel_launch: occupancy query failed (%d)\n", per_cu); per_cu = 1; }
        (void)hipGetLastError();
        grid = cus * per_cu;
        fprintf(stderr, "kernel_launch: %d CUs x %d = grid %d\n", cus, per_cu, grid);
    }
    if (grid < 0) return;
    Args a{};
    for (int i = 0; i < 19; ++i) a.in[i] = (const float*)d_in[i];
    a.out = (float*)d_out; a.ws = (unsigned char*)d_ws;
#if MK_N_LAUNCHES == 1
    a.ph_lo = 0; a.ph_hi = 8;
    void* kargs[] = {&a};
    hipError_t e = hipLaunchCooperativeKernel((const void*)mk_fwd, dim3(grid), dim3(NTHR), kargs, LDS_BYTES, stream);
    if (e != hipSuccess) fprintf(stderr, "kernel_launch: cooperative launch failed: %s (grid %d)\n", hipGetErrorString(e), grid);
#else
    for (int ph = 0; ph < 8; ++ph) { a.ph_lo = ph; a.ph_hi = ph + 1; hipLaunchKernelGGL(mk_fwd, dim3(grid), dim3(NTHR), LDS_BYTES, stream, a); }
#endif
}
```

```cpp
#include <hip/hip_runtime.h>
#include <hip/hip_cooperative_groups.h>
#include <cstdio>
#include <cstdint>
namespace pg8 {
#define PG8_LAS __attribute__((address_space(3)))
typedef unsigned short bf16_t;
typedef short bf16x8 __attribute__((ext_vector_type(8)));
typedef float f32x4 __attribute__((ext_vector_type(4)));
typedef unsigned u32x4 __attribute__((ext_vector_type(4)));
constexpr int BM = 256, BK = 64, HALF = 128, HTB = HALF * BK * 2  , STAGE_BYTES = 8 * HTB, NXCD = 8, WGM = 8;

__host__ __device__ __forceinline__ int lds_byte(int r, int c) { const int st = (r >> 4) * 2 + (c >> 5), rr = r & 15, cc = c & 31, ob = rr * 64 + cc * 2; return st * 1024 + (ob ^ (((ob >> 9) & 1) << 5)); }
__host__ __device__ __forceinline__ void stage_rc(int b, int& R, int& C) { const int st = b / 1024, sb = b % 1024, swz = sb ^ (((sb >> 9) & 1) << 5); R = (st >> 1) * 16 + swz / 64; C = (st & 1) * 32 + (swz % 64) / 2; }
__host__ __device__ __forceinline__ int perm32(int rho) { const int n = rho >> 4, i = rho & 15; return 8 * (i >> 2) + 4 * n + (i & 3); }

struct Unit { int pm, pn; };
struct Gemm { const bf16_t* A; const bf16_t* Bt; int M, N, K; };

struct StaticOrder {
    int nM, nN, nwg, G, c;
    __host__ __device__ void init(int M, int N, int G_, int c_) { nM = M / BM; nN = N / BM; nwg = nM * nN; G = G_; c = c_; }
    __host__ __device__ bool next(int i, Unit& u) const {
        const long L = (long)i * G + c; if (L >= nwg) return false;
        int wgid = (int)L; { const int q = nwg / NXCD, r = nwg % NXCD, xcd = wgid % NXCD, off = wgid / NXCD; wgid = (xcd < r ? xcd * (q + 1) : r * (q + 1) + (xcd - r) * q) + off; }
        const int nig = WGM * nN, gid = wgid / nig, fm = gid * WGM, gsz = (nM - fm) < WGM ? (nM - fm) : WGM;
        u.pm = fm + ((wgid % nig) % gsz); u.pn = (wgid % nig) / gsz; return true;
    }
    __device__ __forceinline__ void a_ready(const Unit&) const {}
    __device__ __forceinline__ void done(const Unit&) const {}
};

__device__ __forceinline__ unsigned cvt_pk_bf16(float lo, float hi) { unsigned r; asm volatile("v_cvt_pk_bf16_f32 %0, %1, %2" : "=v"(r) : "v"(lo), "v"(hi)); return r; }
typedef unsigned u32x2 __attribute__((ext_vector_type(2)));
__device__ __forceinline__ float bf_lo(unsigned w) { return __uint_as_float(w << 16); }
__device__ __forceinline__ float bf_hi(unsigned w) { return __uint_as_float(w & 0xffff0000u); }
__device__ __forceinline__ float dot4(f32x4 a) { return (a[0] * a[0] + a[1] * a[1]) + (a[2] * a[2] + a[3] * a[3]); }

struct EpiZ {
    static constexpr bool PERM = false, AFTER_DRAIN = false;
    bf16_t* Bz; bf16_t* Hh; bf16_t* Uu; const float* rstd0;
    __device__ __forceinline__ void operator()(const f32x4 (&acc)[2][2][4][2], const Unit& u, int ui, int wr, int wc, int fr, int fq) const {
        const int row0 = u.pm * BM + wr * 64 + fr, ch0 = u.pn * 64 + wc * 16 + 4 * fq;
#pragma unroll
        for (int ai = 0; ai < 2; ++ai)
#pragma unroll
            for (int m = 0; m < 4; ++m) { const int r = row0 + ai * HALF + m * 16; const float rs = rstd0[r];
                const f32x4 b = acc[ai][0][m][0] * rs, c = acc[ai][0][m][1] * rs, v = acc[ai][1][m][0] * rs, uu = acc[ai][1][m][1] * rs, h = c * v;
                const size_t off = (size_t)r * 512 + ch0;
                *(u32x2*)(Bz + off) = (u32x2){cvt_pk_bf16(b[0], b[1]), cvt_pk_bf16(b[2], b[3])};
                *(u32x2*)(Hh + off) = (u32x2){cvt_pk_bf16(h[0], h[1]), cvt_pk_bf16(h[2], h[3])};
                *(u32x2*)(Uu + off) = (u32x2){cvt_pk_bf16(uu[0], uu[1]), cvt_pk_bf16(uu[2], uu[3])}; }
    }
};
struct EpiRes {
    static constexpr bool PERM = true, AFTER_DRAIN = false;
    const float* xin_p; const float* xin_s; float* xo; bf16_t* xb; float* ss;
    __device__ __forceinline__ void operator()(const f32x4 (&acc)[2][2][4][2], const Unit& u, int ui, int wr, int wc, int fr, int fq) const {
        const int rl0 = wr * 64 + fr, col0 = u.pn * BM + wc * 32 + 8 * fq;
        const float* xin = (u.pm < 64) ? xin_p + (size_t)u.pm * BM * 1024 : xin_s;
#pragma unroll
        for (int ai = 0; ai < 2; ++ai)
#pragma unroll
            for (int m = 0; m < 4; ++m) { const int rl = rl0 + ai * HALF + m * 16; const size_t ro = (size_t)(u.pm * BM + rl) * 1024 + col0; const float* xi = xin + (size_t)rl * 1024 + col0; float s = 0.f;
#pragma unroll
                for (int bj = 0; bj < 2; ++bj) { const f32x4 x0 = *(const f32x4*)(xi + bj * HALF), x1 = *(const f32x4*)(xi + bj * HALF + 4);
                    const f32x4 o0 = x0 + acc[ai][bj][m][0], o1 = x1 + acc[ai][bj][m][1];
                    *(f32x4*)(xo + ro + bj * HALF) = o0; *(f32x4*)(xo + ro + bj * HALF + 4) = o1;
                    u32x4 w; w.x = cvt_pk_bf16(o0[0], o0[1]); w.y = cvt_pk_bf16(o0[2], o0[3]); w.z = cvt_pk_bf16(o1[0], o1[1]); w.w = cvt_pk_bf16(o1[2], o1[3]);
                    *(u32x4*)(xb + ro + bj * HALF) = w; s += dot4(o0) + dot4(o1); }
                s += __shfl_xor(s, 16); s += __shfl_xor(s, 32);
                if (fq == 0) ss[(size_t)(u.pm * BM + rl) * 16 + u.pn * 4 + wc] = s;
                asm volatile("" ::: "memory"); }
    }
};
struct EpiUp {
    static constexpr bool PERM = true, AFTER_DRAIN = false;
    bf16_t* F; const PG8_LAS float* rs;
    __device__ __forceinline__ void operator()(const f32x4 (&acc)[2][2][4][2], const Unit& u, int ui, int wr, int wc, int fr, int fq) const {
        const int rl0 = wr * 64 + fr, col0 = u.pn * BM + wc * 32 + 8 * fq;
#pragma unroll
        for (int ai = 0; ai < 2; ++ai)
#pragma unroll
            for (int m = 0; m < 4; ++m) { const int rl = rl0 + ai * HALF + m * 16; const float r1 = rs[ui * 256 + rl]; bf16_t* rowp = F + (size_t)(u.pm * BM + rl) * 4096 + col0;
#pragma unroll
                for (int bj = 0; bj < 2; ++bj) { f32x4 v0 = acc[ai][bj][m][0] * r1, v1 = acc[ai][bj][m][1] * r1;
#pragma unroll
                    for (int j = 0; j < 4; ++j) { v0[j] = fmaxf(v0[j], 0.f); v1[j] = fmaxf(v1[j], 0.f); }
                    v0 = v0 * v0; v1 = v1 * v1;
                    u32x4 w; w.x = cvt_pk_bf16(v0[0], v0[1]); w.y = cvt_pk_bf16(v0[2], v0[3]); w.z = cvt_pk_bf16(v1[0], v1[1]); w.w = cvt_pk_bf16(v1[2], v1[3]);
                    *(u32x4*)(rowp + bj * HALF) = w; } }
    }
};
struct EpiBf {
    static constexpr bool PERM = true, AFTER_DRAIN = false;
    bf16_t* O;
    __device__ __forceinline__ void operator()(const f32x4 (&acc)[2][2][4][2], const Unit& u, int ui, int wr, int wc, int fr, int fq) const {
        const int rl0 = wr * 64 + fr, col0 = u.pn * BM + wc * 32 + 8 * fq;
#pragma unroll
        for (int ai = 0; ai < 2; ++ai)
#pragma unroll
            for (int m = 0; m < 4; ++m) { bf16_t* rowp = O + (size_t)(u.pm * BM + rl0 + ai * HALF + m * 16) * 1024 + col0;
#pragma unroll
                for (int bj = 0; bj < 2; ++bj) { const f32x4 v0 = acc[ai][bj][m][0], v1 = acc[ai][bj][m][1];
                    u32x4 w; w.x = cvt_pk_bf16(v0[0], v0[1]); w.y = cvt_pk_bf16(v0[2], v0[3]); w.z = cvt_pk_bf16(v1[0], v1[1]); w.w = cvt_pk_bf16(v1[2], v1[3]);
                    *(u32x4*)(rowp + bj * HALF) = w; } }
    }
};
struct EpiGate {
    static constexpr bool PERM = true, AFTER_DRAIN = false;
    float* X; const bf16_t* PL; const PG8_LAS float* rs; float* ss;
    __device__ __forceinline__ void operator()(const f32x4 (&acc)[2][2][4][2], const Unit& u, int ui, int wr, int wc, int fr, int fq) const {
        const int rl0 = wr * 64 + fr, col0 = u.pn * BM + wc * 32 + 8 * fq;
#pragma unroll
        for (int ai = 0; ai < 2; ++ai)
#pragma unroll
            for (int m = 0; m < 4; ++m) { const int rl = rl0 + ai * HALF + m * 16; const float r1 = rs[ui * 256 + rl] * -1.44269504089f; const size_t ro = (size_t)(u.pm * BM + rl) * 1024 + col0; float s = 0.f;
#pragma unroll
                for (int bj = 0; bj < 2; ++bj) { const f32x4 x0 = *(const f32x4*)(X + ro + bj * HALF), x1 = *(const f32x4*)(X + ro + bj * HALF + 4); const u32x4 pw = *(const u32x4*)(PL + ro + bj * HALF);
                    const f32x4 p0 = (f32x4){bf_lo(pw.x), bf_hi(pw.x), bf_lo(pw.y), bf_hi(pw.y)}, p1 = (f32x4){bf_lo(pw.z), bf_hi(pw.z), bf_lo(pw.w), bf_hi(pw.w)};
                    f32x4 g0 = acc[ai][bj][m][0] * r1, g1 = acc[ai][bj][m][1] * r1;
#pragma unroll
                    for (int j = 0; j < 4; ++j) { g0[j] = __builtin_amdgcn_rcpf(1.0f + __builtin_amdgcn_exp2f(g0[j])); g1[j] = __builtin_amdgcn_rcpf(1.0f + __builtin_amdgcn_exp2f(g1[j])); }
                    const f32x4 o0 = x0 + p0 * g0, o1 = x1 + p1 * g1;
                    *(f32x4*)(X + ro + bj * HALF) = o0; *(f32x4*)(X + ro + bj * HALF + 4) = o1; s += dot4(o0) + dot4(o1); }
                s += __shfl_xor(s, 16); s += __shfl_xor(s, 32);
                if (fq == 0) ss[(size_t)(u.pm * BM + rl) * 16 + u.pn * 4 + wc] = s;
                asm volatile("" ::: "memory"); }
    }
};

template <class Epi, class Sched, bool ALIGN_EPI = false, bool SP2 = false>
__device__ __forceinline__ void gemm_phase(PG8_LAS unsigned char* lds, const Gemm g, const Sched& S, const Epi& E) {
    int tid_ = threadIdx.x; asm volatile("" : "+v"(tid_));
    const int tid = tid_, wid = __builtin_amdgcn_readfirstlane(tid >> 6), lane = tid & 63, wr = wid >> 2, wc = wid & 3, fr = lane & 15, fq = lane >> 4;
    const int K = g.K, nt = K / BK;
    unsigned voffA[2], voffB[2];
#pragma unroll
    for (int i = 0; i < 2; ++i) { int R, C; stage_rc(tid * 16 + i * 8192, R, C); const int Rb = Epi::PERM ? ((R & ~31) + perm32(R & 31)) : R;
        voffA[i] = (unsigned)(R * K + C) * 2u; voffB[i] = (unsigned)(Rb * K + C) * 2u; }
    const size_t kstep = (size_t)(BK * 2);
    const size_t hstep = (size_t)HALF * K * 2;
    const size_t tstep = 2 * hstep;
    const unsigned ldsw = (unsigned)wid * 1024u;
    const int aoff = lds_byte(wr * 64 + fr, fq * 8), boff = lds_byte(wc * 32 + fr, fq * 8);
#define PG8_SA(b, h) (((b) * 2 + (h)) * HTB)
#define PG8_SB(b, h) ((4 + (b) * 2 + (h)) * HTB)
#define PG8_STAGE(bufoff, gbase, voff) do { _Pragma("unroll") for (int _i = 0; _i < 2; ++_i) \
        __builtin_amdgcn_global_load_lds((const unsigned*)((const char*)(gbase) + (voff)[_i]), (PG8_LAS unsigned*)(lds + (bufoff) + ldsw + _i * 8192), 16, 0, 0); } while (0)
#define PG8_LDA(dst, b, h) do { _Pragma("unroll") for (int m = 0; m < 4; ++m) _Pragma("unroll") for (int k = 0; k < 2; ++k) dst[m][k] = *(const PG8_LAS bf16x8*)(lds + PG8_SA(b, h) + aoff + m * 2048 + k * 1024); } while (0)
#define PG8_LDB(dst, b, h) do { _Pragma("unroll") for (int n = 0; n < 2; ++n) _Pragma("unroll") for (int k = 0; k < 2; ++k) dst[n][k] = *(const PG8_LAS bf16x8*)(lds + PG8_SB(b, h) + boff + n * 2048 + k * 1024); } while (0)
#define PG8_MMA(ai, bj, At, Bt) do { __builtin_amdgcn_s_setprio(1); _Pragma("unroll") for (int m = 0; m < 4; ++m) _Pragma("unroll") for (int n = 0; n < 2; ++n) _Pragma("unroll") for (int k = 0; k < 2; ++k) \
        acc[ai][bj][m][n] = __builtin_amdgcn_mfma_f32_16x16x32_bf16(Bt[n][k], At[m][k], acc[ai][bj][m][n], 0, 0, 0); __builtin_amdgcn_s_setprio(0); } while (0)
#define PG8_WAIT_V(n) asm volatile("s_waitcnt vmcnt(" #n ")" ::: "memory")
#define PG8_WAIT_L(n) asm volatile("s_waitcnt lgkmcnt(" #n ")" ::: "memory")
#define PG8_BAR __builtin_amdgcn_s_barrier()
#define PG8_SCHED __builtin_amdgcn_sched_barrier(0)
    Unit cur, nxt; int ui = 0;
    if (!S.next(0, cur)) return;
    f32x4 acc[2][2][4][2];
#pragma unroll
    for (int a = 0; a < 2; ++a)
#pragma unroll
        for (int b = 0; b < 2; ++b)
#pragma unroll
            for (int m = 0; m < 4; ++m)
#pragma unroll
                for (int n = 0; n < 2; ++n) acc[a][b][m][n] = (f32x4){0.f, 0.f, 0.f, 0.f};
    bf16x8 At[4][2], B0[2][2], B1[2][2];
    const char* cA = (const char*)g.A + (size_t)cur.pm * tstep; const char* cB = (const char*)g.Bt + (size_t)cur.pn * tstep;
    S.a_ready(cur);
    if constexpr (SP2) {
        PG8_STAGE(PG8_SB(0, 0), cB, voffB); PG8_STAGE(PG8_SB(0, 1), cB + hstep, voffB); PG8_STAGE(PG8_SA(0, 0), cA, voffA); PG8_STAGE(PG8_SA(0, 1), cA + hstep, voffA);
        if (wr == 1) PG8_BAR;
        PG8_WAIT_V(2); PG8_BAR;
        PG8_STAGE(PG8_SB(1, 0), cB + kstep, voffB); PG8_STAGE(PG8_SA(1, 0), cA + kstep, voffA); PG8_STAGE(PG8_SB(1, 1), cB + hstep + kstep, voffB);
        PG8_WAIT_V(6); PG8_BAR;
    } else {
        PG8_STAGE(PG8_SB(0, 0), cB, voffB); PG8_STAGE(PG8_SA(0, 0), cA, voffA); PG8_STAGE(PG8_SB(0, 1), cB + hstep, voffB); PG8_STAGE(PG8_SA(0, 1), cA + hstep, voffA);
        if (wr == 1) PG8_BAR;
        PG8_WAIT_V(4); PG8_BAR;
        PG8_STAGE(PG8_SB(1, 0), cB + kstep, voffB); PG8_STAGE(PG8_SA(1, 0), cA + kstep, voffA); PG8_STAGE(PG8_SB(1, 1), cB + hstep + kstep, voffB);
        PG8_WAIT_V(6); PG8_BAR;
    }
    for (;;) {
        const bool has_next = S.next(ui + 1, nxt);
        const char* nA = has_next ? (const char*)g.A + (size_t)nxt.pm * tstep : cA; const char* nB = has_next ? (const char*)g.Bt + (size_t)nxt.pn * tstep : cB;
        for (int t = 0; t < nt; t += 2) {
            const bool last = (t == nt - 2);
            const char* a1 = cA + (size_t)(t + 1) * kstep;
            const char* a2 = last ? nA : cA + (size_t)(t + 2) * kstep; const char* b2 = last ? nB : cB + (size_t)(t + 2) * kstep;
            const char* a3 = a2 + kstep; const char* b3 = b2 + kstep;
            if (last && has_next) S.a_ready(nxt);
            if constexpr (SP2) {
            PG8_LDB(B0, 0, 0); PG8_LDB(B1, 0, 1); PG8_SCHED; PG8_LDA(At, 0, 0); PG8_STAGE(PG8_SA(1, 1), a1 + hstep, voffA);
            PG8_WAIT_V(8); PG8_WAIT_L(0); PG8_BAR; PG8_MMA(0, 0, At, B0); PG8_MMA(0, 1, At, B1); PG8_BAR; PG8_SCHED;
            PG8_LDA(At, 0, 1); PG8_STAGE(PG8_SB(0, 0), b2, voffB); PG8_STAGE(PG8_SB(0, 1), b2 + hstep, voffB); PG8_STAGE(PG8_SA(0, 0), a2, voffA);
            PG8_WAIT_V(8); PG8_WAIT_L(0); PG8_BAR; PG8_MMA(1, 0, At, B0); PG8_MMA(1, 1, At, B1); PG8_BAR; PG8_SCHED;
            PG8_LDB(B0, 1, 0); PG8_LDB(B1, 1, 1); PG8_SCHED; PG8_LDA(At, 1, 0); PG8_STAGE(PG8_SA(0, 1), a2 + hstep, voffA);
            PG8_WAIT_V(8); PG8_WAIT_L(0); PG8_BAR; PG8_MMA(0, 0, At, B0); PG8_MMA(0, 1, At, B1); PG8_BAR; PG8_SCHED;
            PG8_LDA(At, 1, 1); PG8_STAGE(PG8_SB(1, 0), b3, voffB); PG8_STAGE(PG8_SB(1, 1), b3 + hstep, voffB); PG8_STAGE(PG8_SA(1, 0), a3, voffA);
            PG8_WAIT_V(8); PG8_WAIT_L(0); PG8_BAR; PG8_MMA(1, 0, At, B0); PG8_MMA(1, 1, At, B1); PG8_BAR; PG8_SCHED;
            } else {
            PG8_LDB(B0, 0, 0); PG8_SCHED; PG8_LDA(At, 0, 0); PG8_STAGE(PG8_SA(1, 1), a1 + hstep, voffA);
            PG8_WAIT_L(8); PG8_BAR; PG8_WAIT_L(0); PG8_MMA(0, 0, At, B0); PG8_BAR; PG8_SCHED;
            PG8_LDB(B1, 0, 1); PG8_STAGE(PG8_SB(0, 0), b2, voffB);
            PG8_BAR; PG8_WAIT_L(0); PG8_MMA(0, 1, At, B1); PG8_BAR;
            PG8_LDA(At, 0, 1); PG8_STAGE(PG8_SA(0, 0), a2, voffA);
            PG8_BAR; PG8_WAIT_L(0); PG8_MMA(1, 0, At, B0); PG8_BAR; PG8_SCHED;
            PG8_STAGE(PG8_SB(0, 1), b2 + hstep, voffB);
            PG8_WAIT_V(6); PG8_BAR; PG8_MMA(1, 1, At, B1); PG8_BAR;
            PG8_LDB(B0, 1, 0); PG8_SCHED; PG8_LDA(At, 1, 0); PG8_STAGE(PG8_SA(0, 1), a2 + hstep, voffA);
            PG8_WAIT_L(8); PG8_BAR; PG8_WAIT_L(0); PG8_MMA(0, 0, At, B0); PG8_BAR; PG8_SCHED;
            PG8_LDB(B1, 1, 1); PG8_STAGE(PG8_SB(1, 0), b3, voffB);
            PG8_BAR; PG8_WAIT_L(0); PG8_MMA(0, 1, At, B1); PG8_BAR;
            PG8_LDA(At, 1, 1); PG8_STAGE(PG8_SA(1, 0), a3, voffA);
            PG8_BAR; PG8_WAIT_L(0); PG8_MMA(1, 0, At, B0); PG8_BAR; PG8_SCHED;
            PG8_STAGE(PG8_SB(1, 1), b3 + hstep, voffB);
            PG8_WAIT_V(6); PG8_BAR; PG8_MMA(1, 1, At, B1); PG8_BAR;
            }
        }
        if constexpr (ALIGN_EPI) { if (wr == 0) PG8_BAR; }
        if constexpr (!Epi::AFTER_DRAIN) { E(acc, cur, ui, wr, wc, fr, fq); S.done(cur); }
        if (!has_next) break;
#pragma unroll
        for (int a = 0; a < 2; ++a)
#pragma unroll
            for (int b = 0; b < 2; ++b)
#pragma unroll
                for (int m = 0; m < 4; ++m)
#pragma unroll
                    for (int n = 0; n < 2; ++n) acc[a][b][m][n] = (f32x4){0.f, 0.f, 0.f, 0.f};
        cur = nxt; cA = nA; cB = nB; ++ui;
        if constexpr (ALIGN_EPI) { if (wr == 1) PG8_BAR; }
    }
    PG8_WAIT_V(0);
    if constexpr (!ALIGN_EPI) { if (wr == 0) PG8_BAR; }
    PG8_BAR;
    if constexpr (Epi::AFTER_DRAIN) { E.fused(acc, cur, wr, wc, fr, fq, lds, wid, lane); S.done(cur); }
#undef PG8_SA
#undef PG8_SB
#undef PG8_STAGE
#undef PG8_LDA
#undef PG8_LDB
#undef PG8_MMA
#undef PG8_WAIT_V
#undef PG8_WAIT_L
#undef PG8_BAR
#undef PG8_SCHED
}
}

#ifndef REP_PHASE
#define REP_PHASE -1
#endif
#ifndef MK_N_LAUNCHES
#define MK_N_LAUNCHES 1
#endif
namespace cg = cooperative_groups;
namespace mk {
#define LAS __attribute__((address_space(3)))
typedef unsigned short bf16;
typedef float f32x4 __attribute__((ext_vector_type(4)));
typedef unsigned u32x4 __attribute__((ext_vector_type(4)));
typedef unsigned u32x2 __attribute__((ext_vector_type(2)));
constexpr int NWAVES = 8, NTHR = 512;
constexpr int D = 1024, MP = 16384, MS = 256, M = MP + MS, NIN = 2048, CW = 512, FF = 4096, PLE = 256, SEQS = 32, NB = 8;
constexpr float EPS = 1e-6f;
constexpr size_t O_Y = 0, O_CP = (size_t)M * D, O_PP = O_CP + 2 * CW, O_CS = O_PP + 15 * CW, O_PS = O_CS + NB * 2 * CW, O_END = O_PS + NB * 15 * CW;
constexpr size_t MiB = 1u << 20;
constexpr size_t WS_CTL = 0, CTL_ZERO_BYTES = 65536;
constexpr size_t WS_RSTD0 = 1 * MiB, WS_SS1 = 2 * MiB, WS_SS2 = 7 * MiB / 2, WS_SS3 = 5 * MiB;
constexpr size_t WS_WIN = 7 * MiB, WS_WOUT = 11 * MiB, WS_WUP = 13 * MiB, WS_WDN = 21 * MiB, WS_WGT = 29 * MiB, WS_WPL = 31 * MiB;
constexpr size_t WS_F = 32 * MiB;
constexpr size_t ZB = (size_t)M * CW * 2;
constexpr size_t WS_BZ = WS_F, WS_H = WS_F + ZB, WS_U = WS_F + 2 * ZB;
constexpr size_t WS_R1 = 162 * MiB;
constexpr size_t WS_R2 = 195 * MiB;
constexpr size_t WS_PB = 228 * MiB;
constexpr size_t WS_END = 237 * MiB;
static_assert(WS_F + (size_t)M * FF * 2 <= WS_R1 && WS_R1 + (size_t)M * D * 2 <= WS_R2 && WS_R2 + (size_t)M * D * 2 <= WS_PB && WS_PB + (size_t)M * PLE * 2 <= WS_END, "ws map");
static_assert((size_t)M * 16 * 4 <= 3 * MiB / 2, "ss size");
constexpr int RING_BYTES = 131072, RS_OFF = RING_BYTES, RS_BYTES = 8 * 256 * 4, MISC_OFF = RS_OFF + RS_BYTES, LDS_BYTES = 147456;

__device__ __forceinline__ unsigned pk2(float lo, float hi) { return pg8::cvt_pk_bf16(lo, hi); }
__device__ __forceinline__ float bflo(unsigned w) { return __uint_as_float(w << 16); }
__device__ __forceinline__ float bfhi(unsigned w) { return __uint_as_float(w & 0xffff0000u); }
__device__ __forceinline__ void unpack8(const u32x4 w, float (&f)[8]) { f[0] = bflo(w.x); f[1] = bfhi(w.x); f[2] = bflo(w.y); f[3] = bfhi(w.y); f[4] = bflo(w.z); f[5] = bfhi(w.z); f[6] = bflo(w.w); f[7] = bfhi(w.w); }
__device__ __forceinline__ u32x4 pack8(const float (&f)[8]) { u32x4 w; w.x = pk2(f[0], f[1]); w.y = pk2(f[2], f[3]); w.z = pk2(f[4], f[5]); w.w = pk2(f[6], f[7]); return w; }
__device__ __forceinline__ float wave_sum(float v) {
#pragma unroll
    for (int o = 1; o < 64; o <<= 1) v += __shfl_xor(v, o);
    return v;
}
#define LDS_WAIT() asm volatile("s_waitcnt lgkmcnt(0)" ::: "memory")

#define XB_TMO      128
#define XB_XCNT(j)  (256  + 64 * (j))
#define XB_XSUB(j)  (1280 + 64 * (j))
#define XB_XGEN(j)  (2304 + 64 * (j))
#define XB_TOP      3328
#define XB_TOPGEN   3392
#define XCD_BAR_WORDS 3456
#define XB_SPIN_CAP (1u << 18)

__device__ __forceinline__ unsigned xb_ld(unsigned* p)              { return __hip_atomic_load(p, __ATOMIC_RELAXED, __HIP_MEMORY_SCOPE_AGENT); }
__device__ __forceinline__ unsigned xb_add(unsigned* p, unsigned v) { return __hip_atomic_fetch_add(p, v, __ATOMIC_RELAXED, __HIP_MEMORY_SCOPE_AGENT); }
__device__ __forceinline__ unsigned xb_xcc_id() { return (unsigned)__builtin_amdgcn_s_getreg((3 << 11) | 20) & 0xFu; }
#define XB_SPIN(cond, bar) do { unsigned _sp = 0; while (cond) { __builtin_amdgcn_s_sleep(1); \
    if ((++_sp & 255u) == 0u) { if (xb_ld(&(bar)[XB_TMO])) break; if (_sp > XB_SPIN_CAP) { atomicAdd(&(bar)[XB_TMO], 1u); break; } } } } while (0)

struct XcdBarrier {
    unsigned* bar; unsigned x;
    volatile LAS unsigned* st;
};

__device__ __forceinline__ XcdBarrier xcd_barrier_post(unsigned* bar, volatile LAS unsigned* st) {
    XcdBarrier b; b.bar = bar; b.x = xb_xcc_id(); b.st = st;
    if (threadIdx.x == 0) (void)xb_add(&bar[XB_XCNT(b.x)], 1u);
    return b;
}
__device__ __forceinline__ void xcd_barrier_complete(unsigned* bar, unsigned x, unsigned& nloc, unsigned& nx) {
    const unsigned G = gridDim.x * gridDim.y * gridDim.z;
    unsigned sum, cnt, mine, sp = 0u;
    for (;;) {
        sum = 0u; cnt = 0u; mine = 0u;
#pragma unroll
        for (unsigned j = 0; j < 16; ++j) { const unsigned c = xb_ld(&bar[XB_XCNT(j)]); sum += c; cnt += (c > 0u) ? 1u : 0u; mine = (j == x) ? c : mine; }
        if (sum == G) break;
        __builtin_amdgcn_s_sleep(1);
        if ((++sp & 255u) == 0u) { if (xb_ld(&bar[XB_TMO])) break; if (sp > XB_SPIN_CAP) { atomicAdd(&bar[XB_TMO], 1u); break; } }
    }
    nloc = mine > 0u ? mine : 1u; nx = cnt > 0u ? cnt : 1u;
}

__device__ __forceinline__ void xcd_barrier(const XcdBarrier& b) {
    asm volatile("s_waitcnt vmcnt(0)" ::: "memory");
    __syncthreads();
    if (threadIdx.x == 0) {
        unsigned* bar = b.bar;
        __builtin_amdgcn_s_waitcnt(0);
        unsigned nloc = b.st[0], nx = b.st[1];
        if (nloc == 0u) { xcd_barrier_complete(bar, b.x, nloc, nx); b.st[0] = nloc; b.st[1] = nx; }
        const unsigned old = xb_add(&bar[XB_XSUB(b.x)], 1u);
        const unsigned gen = old / nloc;
        if (old + 1u == (gen + 1u) * nloc) {
            __builtin_amdgcn_fence(__ATOMIC_RELEASE, "agent");
            asm volatile("s_waitcnt vmcnt(0)" ::: "memory");
            const unsigned og = xb_add(&bar[XB_TOP], 1u);
            const unsigned tg = og / nx;
            if (og + 1u == (tg + 1u) * nx) xb_add(&bar[XB_TOPGEN], 1u);
            else XB_SPIN(xb_ld(&bar[XB_TOPGEN]) == tg, bar);
            __builtin_amdgcn_fence(__ATOMIC_ACQUIRE, "agent");
            xb_add(&bar[XB_XGEN(b.x)], 1u);
            asm volatile("s_waitcnt vmcnt(0)" ::: "memory");
        } else {
            XB_SPIN(xb_ld(&bar[XB_XGEN(b.x)]) == gen, bar);
            __builtin_amdgcn_fence(__ATOMIC_ACQUIRE, "agent");
            asm volatile("s_waitcnt vmcnt(0)" ::: "memory");
        }
    }
    __syncthreads();
}

struct Args { const float* in[19]; float* out; unsigned char* ws; long long ph_lo, ph_hi; };

__device__ __forceinline__ int perm_in(int n) { const int T = n >> 9, ch = n & 511; return (ch >> 6) * 256 + (T >> 1) * 128 + ((ch >> 4) & 3) * 32 + (T & 1) * 16 + (ch & 15); }

__device__ __forceinline__ void transpose_item(const float* W, int N, const float* g, bf16* WT, int ldk, int mode, LAS float* scr, int item, int lane) {
    const int nblk = N / 32, kb = item / nblk, nb = item % nblk, k0 = 64 * kb, n0 = 32 * nb;
#pragma unroll 8
    for (int i = 0; i < 32; ++i) { const int kk = 2 * i + (lane >> 5); float v = W[(size_t)(k0 + kk) * N + n0 + (lane & 31)]; if (g) v *= g[k0 + kk]; scr[kk * 33 + (lane & 31)] = v; }
    LDS_WAIT();
    const int c = lane & 7;
#pragma unroll
    for (int j = 0; j < 4; ++j) { const int n = (lane >> 3) + 8 * j; const LAS float* s = scr + (8 * c) * 33 + n; const int nn = n0 + n; const int row = mode ? perm_in(nn) : nn;
        u32x4 o; o.x = pk2(s[0 * 33], s[1 * 33]); o.y = pk2(s[2 * 33], s[3 * 33]); o.z = pk2(s[4 * 33], s[5 * 33]); o.w = pk2(s[6 * 33], s[7 * 33]);
        *(u32x4*)(WT + (size_t)row * ldk + k0 + 8 * c) = o; }
    LDS_WAIT();
}

__device__ __forceinline__ void p0_prologue(const Args& a, unsigned char* lds, int G) {
    int tid_ = threadIdx.x; asm volatile("" : "+v"(tid_)); const int tid = tid_, lane = tid & 63, wave = __builtin_amdgcn_readfirstlane(tid >> 6);
    const int gw = blockIdx.x * NWAVES + wave, NGW = G * NWAVES;
    unsigned char* ws = a.ws;
    const float *g_mix = a.in[6], *w_in = a.in[7], *w_pool = a.in[9], *pscale = a.in[10], *w_out = a.in[11], *g_mlp = a.in[12], *w_up = a.in[13], *w_down = a.in[14], *g_ple = a.in[15], *w_ple = a.in[16], *w_gate = a.in[17];
    bf16 *Win_t = (bf16*)(ws + WS_WIN), *Wout_t = (bf16*)(ws + WS_WOUT), *Wup_t = (bf16*)(ws + WS_WUP), *Wdn_t = (bf16*)(ws + WS_WDN), *Wgt_t = (bf16*)(ws + WS_WGT), *Wpl_t = (bf16*)(ws + WS_WPL);
    LAS float* scr = (LAS float*)((LAS unsigned char*)lds + wave * 16384);
    for (int T0 = gw; T0 < 1024; T0 += NGW) {
        const int n = (T0 & 15) * 64 + lane, kb = T0 >> 4, g = kb >> 4, c0 = (kb & 15) * 8;
        const f32x4* wp = (const f32x4*)(w_pool + (size_t)(g * 128 + c0) * 128);
#pragma unroll
        for (int j = 0; j < 4; ++j) *(LAS f32x4*)(scr + (lane + 64 * j) * 4) = wp[lane + 64 * j];
        LDS_WAIT();
        float accv[8];
#pragma unroll
        for (int i = 0; i < 8; ++i) accv[i] = 0.f;
        const float* wo = w_out + (size_t)(512 + g * 128) * D + n; const float* sc = pscale + g * 128;
#pragma unroll 32
        for (int d = 0; d < 128; ++d) { const float w = sc[d] * wo[(size_t)d * D];
#pragma unroll
            for (int i = 0; i < 8; ++i) accv[i] += scr[i * 128 + d] * w; }
        *(u32x4*)(Wout_t + (size_t)n * D + 512 + g * 128 + c0) = pack8(accv);
        LDS_WAIT();
    }
    constexpr int I_IN = (D / 64) * (NIN / 32), I_OUT = (512 / 64) * (D / 32), I_UP = (D / 64) * (FF / 32), I_DN = (FF / 64) * (D / 32), I_GT = (D / 64) * (D / 32), I_PL = (PLE / 64) * (D / 32);
    constexpr int NITEMS = I_IN + I_OUT + I_UP + I_DN + I_GT + I_PL;
    for (int it = gw; it < NITEMS; it += NGW) {
        int r = it;
        if (r < I_IN) { transpose_item(w_in, NIN, g_mix, Win_t, D, 1, scr, r, lane); continue; } r -= I_IN;
        if (r < I_OUT) { transpose_item(w_out, D, nullptr, Wout_t, D, 0, scr, r, lane); continue; } r -= I_OUT;
        if (r < I_UP) { transpose_item(w_up, FF, g_mlp, Wup_t, D, 0, scr, r, lane); continue; } r -= I_UP;
        if (r < I_DN) { transpose_item(w_down, D, nullptr, Wdn_t, FF, 0, scr, r, lane); continue; } r -= I_DN;
        if (r < I_GT) { transpose_item(w_gate, D, g_ple, Wgt_t, D, 0, scr, r, lane); continue; } r -= I_GT;
        transpose_item(w_ple, D, nullptr, Wpl_t, PLE, 0, scr, r, lane);
    }
    const float *xp = a.in[0], *xs = a.in[1]; bf16* xb = (bf16*)(ws + WS_R1); float* rstd0 = (float*)(ws + WS_RSTD0);
    for (int m4 = gw; m4 < M / 4; m4 += NGW) {
        const int m = m4 * 4;
        const f32x4* xr = (const f32x4*)(m < MP ? xp + (size_t)m * D : xs + (size_t)(m - MP) * D) + lane;
        f32x4 v[4][4];
#pragma unroll
        for (int q = 0; q < 4; ++q)
#pragma unroll
            for (int j = 0; j < 4; ++j) v[q][j] = xr[q * (D / 4) + 64 * j];
#pragma unroll
        for (int q = 0; q < 4; ++q) { float s = 0.f;
#pragma unroll
            for (int j = 0; j < 4; ++j) s += (v[q][j][0] * v[q][j][0] + v[q][j][1] * v[q][j][1]) + (v[q][j][2] * v[q][j][2] + v[q][j][3] * v[q][j][3]);
            s = wave_sum(s);
            if (lane == 0) rstd0[m + q] = rsqrtf(s * (1.f / D) + EPS);
            u32x2* o = (u32x2*)(xb + (size_t)(m + q) * D) + lane;
#pragma unroll
            for (int j = 0; j < 4; ++j) o[64 * j] = (u32x2){pk2(v[q][j][0], v[q][j][1]), pk2(v[q][j][2], v[q][j][3])}; }
    }
    const float *pp = a.in[4], *ps = a.in[5]; bf16* pb = (bf16*)(ws + WS_PB);
    for (int i = blockIdx.x * NTHR + tid; i < M * PLE / 8; i += G * NTHR) {
        const f32x4* src = (const f32x4*)(i < MP * PLE / 8 ? pp + (size_t)i * 8 : ps + (size_t)(i - MP * PLE / 8) * 8);
        const f32x4 v0 = src[0], v1 = src[1]; u32x4 w; w.x = pk2(v0[0], v0[1]); w.y = pk2(v0[2], v0[3]); w.z = pk2(v1[0], v1[1]); w.w = pk2(v1[2], v1[3]);
        *(u32x4*)(pb + (size_t)i * 8) = w;
    }
}

__device__ __forceinline__ const bf16* zrow(const unsigned char* zb, int T, int r) { return (const bf16*)(zb + (size_t)T * ZB + (size_t)r * (CW * 2)); }
__device__ __forceinline__ u32x4 pack8f(const float* p) { const f32x4 a = *(const f32x4*)p, b = *(const f32x4*)(p + 4); u32x4 w; w.x = pk2(a[0], a[1]); w.y = pk2(a[2], a[3]); w.z = pk2(b[0], b[1]); w.w = pk2(b[2], b[3]); return w; }
template <int W> __device__ __forceinline__ void pool_chunk(const unsigned char* zb, const float* st_pool, bf16* mixA, int r0, int pc, bool samp) {
    const int t0 = samp ? ((r0 - MP) & (SEQS - 1)) : r0, b = samp ? ((r0 - MP) >> 5) : 0;
    u32x4 uw[W + 7];
#pragma unroll
    for (int i = 0; i < W + 7; ++i) { const int tt = t0 - (W - 1) + i;
        if (tt >= 0) uw[i] = *(const u32x4*)(zrow(zb, 2, r0 - (W - 1) + i) + pc);
        else if (samp) uw[i] = pack8f(st_pool + (size_t)(b * 15 + 15 + tt) * CW + pc);
        else uw[i] = (u32x4){0u, 0u, 0u, 0u}; }
    float s[8], x[8];
#pragma unroll
    for (int e = 0; e < 8; ++e) s[e] = 0.f;
#pragma unroll
    for (int i = 0; i < W - 1; ++i) { unpack8(uw[i], x);
#pragma unroll
        for (int e = 0; e < 8; ++e) s[e] += x[e]; }
#pragma unroll
    for (int j = 0; j < 8; ++j) { float o[8], y[8]; unpack8(uw[j + W - 1], x);
#pragma unroll
        for (int e = 0; e < 8; ++e) s[e] += x[e];
        const int cnt = samp ? W : (t0 + j + 1 < W ? t0 + j + 1 : W); const float inv = 1.0f / (float)cnt;
#pragma unroll
        for (int e = 0; e < 8; ++e) o[e] = s[e] * inv - x[e];
        *(u32x4*)(mixA + (size_t)(r0 + j) * D + CW + pc) = pack8(o);
        unpack8(uw[j], y);
#pragma unroll
        for (int e = 0; e < 8; ++e) s[e] -= y[e]; }
}
__device__ __forceinline__ void p2_item(const Args& a, const unsigned char* zb, int pm, int q) {
    int tid_ = threadIdx.x; asm volatile("" : "+v"(tid_)); const int tid = tid_, lane = tid & 63, wave = __builtin_amdgcn_readfirstlane(tid >> 6);
    bf16* mixA = (bf16*)(a.ws + WS_R1);
    const float *st_conv = a.in[2], *st_pool = a.in[3], *w_conv = a.in[8];
    const int R0 = pm * 256 + q * 64; const bool samp = (pm == 64);
    {
        const int r0 = R0 + 8 * wave, ch = lane * 8; const int t0 = samp ? ((r0 - MP) & (SEQS - 1)) : r0, b = samp ? ((r0 - MP) >> 5) : 0;
        u32x4 hw[8], bw[8]; float hm2[8], hm1[8], w0[8], w1[8], w2[8];
#pragma unroll
        for (int j = 0; j < 8; ++j) { hw[j] = *(const u32x4*)(zrow(zb, 1, r0 + j) + ch); bw[j] = *(const u32x4*)(zrow(zb, 0, r0 + j) + ch); }
        if (t0 >= 2) { unpack8(*(const u32x4*)(zrow(zb, 1, r0 - 2) + ch), hm2); unpack8(*(const u32x4*)(zrow(zb, 1, r0 - 1) + ch), hm1); }
        else {
#pragma unroll
            for (int e = 0; e < 8; ++e) { hm2[e] = samp ? st_conv[(size_t)(b * 2 + 0) * CW + ch + e] : 0.f; hm1[e] = samp ? st_conv[(size_t)(b * 2 + 1) * CW + ch + e] : 0.f; } }
#pragma unroll
        for (int e = 0; e < 8; ++e) { w0[e] = w_conv[ch + e]; w1[e] = w_conv[CW + ch + e]; w2[e] = w_conv[2 * CW + ch + e]; }
#pragma unroll
        for (int j = 0; j < 8; ++j) { float h0[8], bz[8], o[8]; unpack8(hw[j], h0); unpack8(bw[j], bz);
#pragma unroll
            for (int e = 0; e < 8; ++e) { o[e] = bz[e] * (w0[e] * hm2[e] + w1[e] * hm1[e] + w2[e] * h0[e]); hm2[e] = hm1[e]; hm1[e] = h0[e]; }
            *(u32x4*)(mixA + (size_t)(r0 + j) * D + ch) = pack8(o); }
    }
    {
        const int g = wave & 3, r0 = R0 + (wave >> 2) * 32 + (lane >> 4) * 8, pc = g * 128 + (lane & 15) * 8;
        if (g == 0) pool_chunk<2>(zb, st_pool, mixA, r0, pc, samp);
        else if (g == 1) pool_chunk<4>(zb, st_pool, mixA, r0, pc, samp);
        else if (g == 2) pool_chunk<8>(zb, st_pool, mixA, r0, pc, samp);
        else pool_chunk<16>(zb, st_pool, mixA, r0, pc, samp);
    }
    float* out = a.out;
    if (pm == 63 && q == 3) {
        for (int e = tid; e < 17 * CW; e += NTHR) { const int j = e >> 9, c = e & 511;
            if (j < 2) out[O_CP + e] = __uint_as_float((unsigned)zrow(zb, 1, MP - 2 + j)[c] << 16);
            else out[O_PP + e - 2 * CW] = __uint_as_float((unsigned)zrow(zb, 2, MP - 15 + (j - 2))[c] << 16); }
    }
    if (samp) {
        for (int e = tid; e < 2 * 17 * CW; e += NTHR) { const int bb = e / (17 * CW), rem = e - bb * 17 * CW, j = rem >> 9, c = rem & 511, b = 2 * q + bb, rb = MP + b * SEQS;
            if (j < 2) out[O_CS + (size_t)(b * 2 + j) * CW + c] = __uint_as_float((unsigned)zrow(zb, 1, rb + SEQS - 2 + j)[c] << 16);
            else out[O_PS + (size_t)(b * 15 + (j - 2)) * CW + c] = __uint_as_float((unsigned)zrow(zb, 2, rb + SEQS - 15 + (j - 2))[c] << 16); }
    }
}

template <class Sched> __device__ __forceinline__ void fill_rstd(LAS float* rs, const Sched& S, const float* ss) {
    pg8::Unit u; const int row = threadIdx.x >> 1, half = threadIdx.x & 1;
    for (int i = 0; i < 8 && S.next(i, u); ++i) {
        const f32x4* p = (const f32x4*)(ss + (size_t)(u.pm * 256 + row) * 16 + half * 8);
        const f32x4 x = p[0], y = p[1]; float s = ((x[0] + x[1]) + (x[2] + x[3])) + ((y[0] + y[1]) + (y[2] + y[3]));
        s += __shfl_xor(s, 1);
        if (half == 0) rs[i * 256 + row] = rsqrtf(s * (1.f / D) + EPS);
    }
    __syncthreads();
}

__device__ __forceinline__ void p7_item(const Args& a, int pm, int q) {
    int tid_ = threadIdx.x; asm volatile("" : "+v"(tid_)); const int tid = tid_, lane = tid & 63, wave = __builtin_amdgcn_readfirstlane(tid >> 6);
    const float* ss3 = (const float*)(a.ws + WS_SS3); const f32x4* gf = (const f32x4*)a.in[18] + lane;
    f32x4 gv[4];
#pragma unroll
    for (int j = 0; j < 4; ++j) gv[j] = gf[64 * j];
    const int r0 = pm * 256 + q * 64 + wave * 8;
#pragma unroll
    for (int h = 0; h < 2; ++h) { f32x4 v[4][4]; float sp[4];
#pragma unroll
        for (int k = 0; k < 4; ++k) { const int m = r0 + 4 * h + k; sp[k] = ss3[(size_t)m * 16 + (lane & 15)]; const f32x4* xr = (const f32x4*)(a.out + (size_t)m * D) + lane;
#pragma unroll
            for (int j = 0; j < 4; ++j) v[k][j] = xr[64 * j]; }
#pragma unroll
        for (int k = 0; k < 4; ++k) { float s = sp[k]; s += __shfl_xor(s, 1); s += __shfl_xor(s, 2); s += __shfl_xor(s, 4); s += __shfl_xor(s, 8);
            const float rstd = rsqrtf(s * (1.f / D) + EPS); f32x4* xw = (f32x4*)(a.out + (size_t)(r0 + 4 * h + k) * D) + lane;
#pragma unroll
            for (int j = 0; j < 4; ++j) xw[64 * j] = v[k][j] * gv[j] * rstd; } }
}

__global__ void __launch_bounds__(NTHR, 2) mk_fwd(Args a) {
    extern __shared__ __attribute__((aligned(16))) unsigned char lds[];
    PG8_LAS unsigned char* L = (PG8_LAS unsigned char*)lds;
    LAS float* rs = (LAS float*)(L + RS_OFF);
    const int G = gridDim.x, c = blockIdx.x;
    unsigned char* ws = a.ws;
    const int lo = (int)a.ph_lo, hi = (int)a.ph_hi;
#define IN(k) (lo <= (k) && (k) < hi)
#define SEAM(k) do { if (IN(k) && IN((k) + 1)) xcd_barrier(bar); } while (0)
    if (a.ph_hi < 0) cg::this_grid().sync();
    volatile LAS unsigned* MISC = (volatile LAS unsigned*)(L + MISC_OFF);
    if (threadIdx.x < 2) MISC[threadIdx.x] = 0u;
    __syncthreads();
    XcdBarrier bar = xcd_barrier_post((unsigned*)(ws + WS_CTL), MISC);
    bf16 *Win_t = (bf16*)(ws + WS_WIN), *Wout_t = (bf16*)(ws + WS_WOUT), *Wup_t = (bf16*)(ws + WS_WUP), *Wdn_t = (bf16*)(ws + WS_WDN), *Wgt_t = (bf16*)(ws + WS_WGT), *Wpl_t = (bf16*)(ws + WS_WPL);
    bf16 *R1 = (bf16*)(ws + WS_R1), *R2 = (bf16*)(ws + WS_R2), *PB = (bf16*)(ws + WS_PB), *Fb = (bf16*)(ws + WS_F);
    float *ss1 = (float*)(ws + WS_SS1), *ss2 = (float*)(ws + WS_SS2), *ss3 = (float*)(ws + WS_SS3);

    if (IN(0)) { p0_prologue(a, lds, G); if (REP_PHASE == 0) { xcd_barrier(bar); p0_prologue(a, lds, G); } } SEAM(0);
    if (IN(1)) {
        pg8::Gemm g{R1, Win_t, M, NIN, D}; pg8::StaticOrder S; S.init(M, NIN, G, c);
        pg8::EpiZ E{(bf16*)(ws + WS_BZ), (bf16*)(ws + WS_H), (bf16*)(ws + WS_U), (const float*)(ws + WS_RSTD0)};
        pg8::gemm_phase<pg8::EpiZ, pg8::StaticOrder, true, true>(L, g, S, E);
    } SEAM(1);
    if (IN(2)) { for (int rep = 0; rep < (REP_PHASE == 2 ? 2 : 1); ++rep) for (int it = c; it < 260; it += G) p2_item(a, ws + WS_BZ, it >> 2, it & 3); } SEAM(2);
    if (IN(3)) {
        pg8::Gemm g{R1, Wout_t, M, D, D}; pg8::StaticOrder S; S.init(M, D, G, c);
        pg8::EpiRes E{a.in[0], a.in[1], a.out, R2, ss1};
        pg8::gemm_phase<pg8::EpiRes, pg8::StaticOrder, true, true>(L, g, S, E);
    } SEAM(3);
    if (IN(4)) {
        pg8::Gemm g{R2, Wup_t, M, FF, D}; pg8::StaticOrder S; S.init(M, FF, G, c);
        fill_rstd(rs, S, ss1);
        pg8::EpiUp E{Fb, (const PG8_LAS float*)rs};
        pg8::gemm_phase<pg8::EpiUp, pg8::StaticOrder, true, true>(L, g, S, E);
        if (REP_PHASE == 4) { xcd_barrier(bar); pg8::gemm_phase<pg8::EpiUp, pg8::StaticOrder, true, true>(L, g, S, E); }
    } SEAM(4);
    if (IN(5)) {
        { pg8::Gemm g{Fb, Wdn_t, M, D, FF}; pg8::StaticOrder S; S.init(M, D, G, c);
          pg8::EpiRes E{a.out, a.out + (size_t)MP * D, a.out, R1, ss2};
          pg8::gemm_phase<pg8::EpiRes, pg8::StaticOrder, true, true>(L, g, S, E); }
        { pg8::Gemm g{PB, Wpl_t, M, D, PLE}; pg8::StaticOrder S; S.init(M, D, G, c);
          pg8::EpiBf E{R2};
          pg8::gemm_phase<pg8::EpiBf, pg8::StaticOrder, true, true>(L, g, S, E); }
    } SEAM(5);
    if (IN(6)) {
        pg8::Gemm g{R1, Wgt_t, M, D, D}; pg8::StaticOrder S; S.init(M, D, G, c);
        fill_rstd(rs, S, ss2);
        pg8::EpiGate E{a.out, R2, (const PG8_LAS float*)rs, ss3};
        pg8::gemm_phase<pg8::EpiGate, pg8::StaticOrder, true, true>(L, g, S, E);
    } SEAM(6);
    if (REP_PHASE == 9) { for (int k = 0; k < 8; ++k) xcd_barrier(bar); }
    if (IN(7)) { for (int it = c; it < 260; it += G) p7_item(a, it >> 2, it & 3); }
#undef IN
#undef SEAM
}
}

extern "C" void kernel_launch(void* const* d_in, const int* in_sizes, int n_in, void* d_out, int out_size, void* d_ws, size_t ws_size, hipStream_t stream) {
    using namespace mk;
    static int grid = 0;
    if (grid == 0) {
        if (n_in != 19 || out_size != (int)O_END || ws_size < WS_END) { fprintf(stderr, "kernel_launch: unexpected shapes (n_in %d, out %d, ws %zu)\n", n_in, out_size, ws_size); grid = -1; return; }
        int dev = 0, cus = 0, per_cu = 0;
        (void)hipGetDevice(&dev); (void)hipDeviceGetAttribute(&cus, hipDeviceAttributeMultiprocessorCount, dev);
        if (hipFuncSetAttribute((const void*)mk_fwd, hipFuncAttributeMaxDynamicSharedMemorySize, LDS_BYTES) != hipSuccess) { fprintf(stderr, "kernel_launch: hipFuncSetAttribute failed\n"); grid = -1; return; }
        if (hipOccupancyMaxActiveBlocksPerMultiprocessor(&per_cu, (const void*)mk_fwd, NTHR, LDS_BYTES) != hipSuccess || per_cu < 1) { fprintf(stderr, "kernel_launch: occupancy query failed (%d)\n", per_cu); per_cu = 1; }
        (void)hipGetLastError();
        grid = cus * per_cu;
        fprintf(stderr, "kernel_launch: %d CUs x %d = grid %d\n", cus, per_cu, grid);
    }
    if (grid < 0) return;
    if (hipMemsetAsync((char*)d_ws + WS_CTL, 0, CTL_ZERO_BYTES, stream) != hipSuccess) { fprintf(stderr, "kernel_launch: memset failed\n"); return; }
    Args a{};
    for (int i = 0; i < 19; ++i) a.in[i] = (const float*)d_in[i];
    a.out = (float*)d_out; a.ws = (unsigned char*)d_ws;
#if MK_N_LAUNCHES == 1
    a.ph_lo = 0; a.ph_hi = 8;
    void* kargs[] = {&a};
    hipError_t e = hipLaunchCooperativeKernel((const void*)mk_fwd, dim3(grid), dim3(NTHR), kargs, LDS_BYTES, stream);
    if (e != hipSuccess) fprintf(stderr, "kernel_launch: cooperative launch failed: %s (grid %d)\n", hipGetErrorString(e), grid);
#else
    for (int ph = 0; ph < 8; ++ph) { a.ph_lo = ph; a.ph_hi = ph + 1; hipLaunchKernelGGL(mk_fwd, dim3(grid), dim3(NTHR), LDS_BYTES, stream, a); }
#endif
}
```
